# Optimizing an MI355X kernel written in HIP

```python
import math
import jax, jax.numpy as jnp
from jax import lax
import numpy as np

D_MODEL = 1024
BATCH = 8
SEQ = 4096
DEPTH = 1

N_META = 16
BLOCK = 128
MLA_HEADS = 8
QK_NOPE = 64
QK_ROPE = 32
V_HEAD = 64
Q_LORA = 256
KV_LORA = 128
ROPE_THETA = 10000.0
MLA_WIDTH = MLA_HEADS * V_HEAD
CONV_CH = 512
CONV_K = 31
CONV_WIDTH = CONV_CH
MIX_WIDTH = MLA_WIDTH + CONV_WIDTH
IN_COLS = 2 * CONV_CH + Q_LORA + KV_LORA + QK_ROPE
N_KEYS = 128
N_EXPERTS = N_KEYS * N_KEYS
PEER_HEADS = 8
PEER_DK = 128
PEER_DK_HALF = PEER_DK // 2
PEER_TOPK = 16
PEER_CHUNK = 128
NORM_EPS = 1e-6

kernel_name = "hymba_conformer_mla_peer_block"


def rmsnorm(x, g):
    xf = x.astype(jnp.float32)
    y = xf * lax.rsqrt(jnp.mean(xf * xf, axis=-1, keepdims=True) + NORM_EPS)
    return (y * g.astype(jnp.float32)).astype(x.dtype)


def layernorm(x, g, b):
    xf = x.astype(jnp.float32)
    mu = jnp.mean(xf, axis=-1, keepdims=True)
    var = jnp.mean(jnp.square(xf - mu), axis=-1, keepdims=True)
    y = (xf - mu) * lax.rsqrt(var + NORM_EPS)
    return (y * g.astype(jnp.float32) + b.astype(jnp.float32)).astype(x.dtype)


def rope(x, pos):
    half = x.shape[-1] // 2
    freqs = ROPE_THETA ** (-jnp.arange(half, dtype=jnp.float32) / half)
    ang = pos.astype(jnp.float32)[:, None] * freqs[None, :]
    cos = jnp.cos(ang)[None, :, None, :].astype(x.dtype)
    sin = jnp.sin(ang)[None, :, None, :].astype(x.dtype)
    x1, x2 = x[..., :half], x[..., half:]
    return jnp.concatenate([x1 * cos - x2 * sin, x2 * cos + x1 * sin], axis=-1)


def causal_block_attention(q, k, v):
    B, Tp, H, Dq = q.shape
    nb = Tp // BLOCK
    qb = q.reshape(B, nb, BLOCK, H, Dq).transpose(1, 0, 2, 3, 4)
    kpos = jnp.arange(Tp)
    scale = 1.0 / math.sqrt(Dq)

    def one(args):
        qblk, i = args
        s = jnp.einsum('bqhd,bkhd->bhqk', qblk, k).astype(jnp.float32) * scale
        qpos = i * BLOCK + jnp.arange(BLOCK)
        mask = kpos[None, :] <= qpos[:, None]
        s = jnp.where(mask[None, None], s, -jnp.inf)
        p = jax.nn.softmax(s, axis=-1).astype(v.dtype)
        return jnp.einsum('bhqk,bkhd->bqhd', p, v)

    o = lax.map(one, (qb, jnp.arange(nb)))
    return o.transpose(1, 0, 2, 3, 4).reshape(B, Tp, H, v.shape[-1])


def mla_group(c_q, c_kv, k_rope_in, pos, g_q, w_uq, g_kv, w_ukv):
    B, Tp, _ = c_q.shape
    q = (rmsnorm(c_q, g_q) @ w_uq).reshape(B, Tp, MLA_HEADS, QK_NOPE + QK_ROPE)
    q = jnp.concatenate([q[..., :QK_NOPE], rope(q[..., QK_NOPE:], pos)], axis=-1)
    kv = (rmsnorm(c_kv, g_kv) @ w_ukv).reshape(B, Tp, MLA_HEADS, QK_NOPE + V_HEAD)
    k_nope, v = kv[..., :QK_NOPE], kv[..., QK_NOPE:]
    k_r = rope(k_rope_in[:, :, None, :], pos)
    k = jnp.concatenate([k_nope, jnp.broadcast_to(k_r, (B, Tp, MLA_HEADS, QK_ROPE))], axis=-1)
    o = causal_block_attention(q, k, v)
    return o.reshape(B, Tp, MLA_WIDTH)


def conv_group(a, b, conv_w, conv_b, g_ln, b_ln):
    h = a * jax.nn.sigmoid(b)
    h = lax.conv_general_dilated(h, conv_w[:, None, :].astype(h.dtype), window_strides=(1,),
                                 padding=[(CONV_K - 1, 0)],
                                 dimension_numbers=('NWC', 'WIO', 'NWC'),
                                 feature_group_count=CONV_CH) + conv_b
    h = layernorm(h, g_ln, b_ln)
    return jax.nn.silu(h)


def peer_ffn(xn, wq, keys, u_tab, v_tab):
    B, Tp, D = xn.shape
    xc = xn.reshape(-1, PEER_CHUNK, D)
    K = PEER_TOPK

    def one(xb):
        C = xb.shape[0]
        q = (xb @ wq).reshape(C, PEER_HEADS, 2, PEER_DK_HALF)
        s = jnp.einsum('chpd,hpnd->chpn', q, keys).astype(jnp.float32)
        sv, si = lax.top_k(s, K)
        cand = sv[:, :, 0, :, None] + sv[:, :, 1, None, :]
        cidx = si[:, :, 0, :, None] * N_KEYS + si[:, :, 1, None, :]
        top_s, sel = lax.top_k(cand.reshape(C, PEER_HEADS, K * K), K)
        eidx = jnp.take_along_axis(cidx.reshape(C, PEER_HEADS, K * K), sel, axis=-1)
        g = jax.nn.softmax(top_s, axis=-1)
        u = u_tab[eidx]
        act = jax.nn.gelu(jnp.einsum('chkd,cd->chk', u, xb).astype(jnp.float32), approximate=False)
        w = (g * act).astype(xb.dtype)
        return jnp.einsum('chk,chkd->cd', w, v_tab[eidx])

    return lax.map(one, xc).reshape(B, Tp, D)


def setup_inputs(seed: int = 0) -> dict:
    key = jax.random.key(seed)
    ks = jax.random.split(key, 24)
    f32 = jnp.float32
    L, D = DEPTH, D_MODEL

    def nrm(k, shape, scale):
        return jax.random.normal(k, shape, f32) * scale

    def gain(k, shape):
        return 1.0 + 0.02 * jax.random.normal(k, shape, f32)

    return {
        "x": jax.random.normal(ks[0], (BATCH, SEQ, D), f32),
        "meta": nrm(ks[1], (N_META, D), 1.0),
        "g_mix_norm": gain(ks[2], (L, D)),
        "w_in": nrm(ks[3], (L, D, IN_COLS), D ** -0.5),
        "g_q": gain(ks[4], (L, Q_LORA)),
        "w_uq": nrm(ks[5], (L, Q_LORA, MLA_HEADS * (QK_NOPE + QK_ROPE)), Q_LORA ** -0.5),
        "g_kv": gain(ks[6], (L, KV_LORA)),
        "w_ukv": nrm(ks[7], (L, KV_LORA, MLA_HEADS * (QK_NOPE + V_HEAD)), KV_LORA ** -0.5),
        "conv_w": nrm(ks[8], (L, CONV_K, CONV_CH), CONV_K ** -0.5),
        "conv_b": nrm(ks[9], (L, CONV_CH), 0.02),
        "g_conv_ln": gain(ks[10], (L, CONV_CH)),
        "b_conv_ln": nrm(ks[11], (L, CONV_CH), 0.02),
        "g_out_attn": gain(ks[12], (L, MLA_WIDTH)),
        "g_out_conv": gain(ks[13], (L, CONV_WIDTH)),
        "w_out": nrm(ks[14], (L, MIX_WIDTH, D), MIX_WIDTH ** -0.5),
        "g_ffn_norm": gain(ks[15], (L, D)),
        "peer_wq": nrm(ks[16], (L, D, PEER_HEADS * PEER_DK), D ** -0.5),
        "peer_keys": nrm(ks[17], (L, PEER_HEADS, 2, N_KEYS, PEER_DK_HALF), PEER_DK_HALF ** -0.5),
        "peer_u": nrm(ks[18], (L, N_EXPERTS, D), D ** -0.5),
        "peer_v": nrm(ks[19], (L, N_EXPERTS, D), (PEER_HEADS * PEER_TOPK) ** -0.5),
        "g_final": gain(ks[20], (D,)),
    }


def reference(x, meta, g_mix_norm, w_in, g_q, w_uq, g_kv, w_ukv, conv_w, conv_b, g_conv_ln, b_conv_ln,
              g_out_attn, g_out_conv, w_out, g_ffn_norm, peer_wq, peer_keys, peer_u, peer_v, g_final):
    B, S, D = x.shape
    T = N_META + S
    Tp = ((T + BLOCK - 1) // BLOCK) * BLOCK
    h = jnp.concatenate([jnp.broadcast_to(meta.astype(x.dtype)[None], (B, N_META, D)), x,
                         jnp.zeros((B, Tp - T, D), x.dtype)], axis=1)
    pos = jnp.arange(Tp, dtype=jnp.int32)

    c0 = 2 * CONV_CH
    c1 = c0 + Q_LORA
    c2 = c1 + KV_LORA
    for l in range(DEPTH):
        hn = rmsnorm(h, g_mix_norm[l])
        z = hn @ w_in[l]
        conv_out = conv_group(z[..., :CONV_CH], z[..., CONV_CH:c0], conv_w[l], conv_b[l],
                              g_conv_ln[l], b_conv_ln[l])
        attn_out = mla_group(z[..., c0:c1], z[..., c1:c2], z[..., c2:], pos,
                             g_q[l], w_uq[l], g_kv[l], w_ukv[l])
        mixed = jnp.concatenate([rmsnorm(attn_out, g_out_attn[l]),
                                 rmsnorm(conv_out, g_out_conv[l])], axis=-1)
        h = h + mixed @ w_out[l]
        h = h + peer_ffn(rmsnorm(h, g_ffn_norm[l]), peer_wq[l], peer_keys[l], peer_u[l], peer_v[l])

    h = rmsnorm(h, g_final)
    return h[:, N_META:N_META + S, :]
```

```cpp
#include <hip/hip_runtime.h>
#include <hip/hip_cooperative_groups.h>
#include <stdint.h>
#include <cstdio>
namespace cg = cooperative_groups;

#ifndef MEGA
#define MEGA 1
#endif
#ifndef NAIVE_GEMM
#define NAIVE_GEMM 0
#endif
#ifndef NAIVE_ATTN
#define NAIVE_ATTN 0
#endif

#define DEVI __device__ __forceinline__

constexpr int DM = 1024;
constexpr int NBATCH = 8;
constexpr int SEQ = 4096;
constexpr int NMETA = 16;
constexpr int TP = 4224;
constexpr int NTOK = NBATCH * TP;
constexpr int NREAL = NBATCH * SEQ;
constexpr int ZW = 1408;
constexpr float EPS = 1e-6f;
constexpr float QSCALE = 0.14724574f;
constexpr float USCALE = 256.f, VSCALE = 64.f;

constexpr size_t al256(size_t x) { return (x + 255) & ~(size_t)255; }
constexpr size_t WS_WT_IN = 0;
constexpr size_t WS_WT_UQ = WS_WT_IN + al256((size_t)1536 * 1024 * 2);
constexpr size_t WS_WT_UK = WS_WT_UQ + al256((size_t)768 * 256 * 2);
constexpr size_t WS_WT_UV = WS_WT_UK + al256((size_t)512 * 128 * 2);
constexpr size_t WS_WT_OUT = WS_WT_UV + al256((size_t)512 * 128 * 2);
constexpr size_t WS_WT_PQ = WS_WT_OUT + al256((size_t)1024 * 1024 * 2);
constexpr size_t WS_KEYS = WS_WT_PQ + al256((size_t)1024 * 1024 * 2);
constexpr size_t WS_ROPE = WS_KEYS + al256((size_t)8 * 2 * 128 * 64 * 2);
constexpr size_t WS_U8 = WS_ROPE + al256((size_t)TP * 16 * 2 * 4);
constexpr size_t WS_V8 = WS_U8 + al256((size_t)16384 * 1024);
constexpr size_t WS_MIXED = WS_V8 + al256((size_t)16384 * 1024);
constexpr size_t WS_HB = WS_MIXED + al256((size_t)NTOK * 1024 * 2);
constexpr size_t WS_R1 = WS_HB + al256((size_t)NTOK * 1024 * 2);
constexpr size_t WS_Z = WS_R1;
constexpr size_t WS_KROPE = WS_Z + al256((size_t)NTOK * ZW * 2);
constexpr size_t WS_Q = WS_KROPE + al256((size_t)NTOK * 32 * 2);
constexpr size_t WS_KN = WS_Q + al256((size_t)NTOK * 768 * 2);
constexpr size_t WS_VT = WS_KN + al256((size_t)NTOK * 512 * 2);
constexpr size_t WS_R1_END = WS_VT + al256((size_t)NTOK * 512 * 2);
constexpr size_t WS_H2 = WS_R1;
constexpr size_t WS_SELI = WS_H2 + al256((size_t)NREAL * 1024 * 4);
constexpr size_t WS_SELG = WS_SELI + al256((size_t)NREAL * 128 * 4);
constexpr size_t WS_SEL_END = WS_SELG + al256((size_t)NREAL * 128 * 4);
static_assert(WS_SEL_END <= WS_R1_END, "overlay does not fit");
constexpr size_t WS_BAR = WS_R1_END;
constexpr size_t WS_BAR_BYTES = 16384;
constexpr size_t WS_TOTAL = WS_BAR + WS_BAR_BYTES;

constexpr int LDS_AS = 0;
constexpr int LDS_BS = 36864;
constexpr int LDS_RS = 73728;
constexpr int LDS_SCR = 73728 + 512;
constexpr int LDS_BYTES = LDS_SCR + 1024;
constexpr int CT_LD = 132;

struct P {
  const float* in[21];
  float* out;
  char* ws;
};

DEVI uint32_t f2bf(float f) { uint32_t u = __float_as_uint(f); return (u + 0x7fffu + ((u >> 16) & 1u)) >> 16; }
DEVI float bflo(uint32_t w) { return __uint_as_float(w << 16); }
DEVI float bfhi(uint32_t w) { return __uint_as_float(w & 0xffff0000u); }
DEVI float bf1(uint16_t h) { return __uint_as_float(((uint32_t)h) << 16); }
typedef __bf16 hwbf16x2 __attribute__((ext_vector_type(2)));
typedef float hwf32x2 __attribute__((ext_vector_type(2)));
DEVI uint32_t pk(float a, float b) { const hwf32x2 v = {a, b}; return __builtin_bit_cast(uint32_t, __builtin_convertvector(v, hwbf16x2)); }
DEVI float wsum16(float v) {
  v += __shfl_xor(v, 1); v += __shfl_xor(v, 2); v += __shfl_xor(v, 4); v += __shfl_xor(v, 8); return v;
}
DEVI float wsum64(float v) { v = wsum16(v); v += __shfl_xor(v, 16); v += __shfl_xor(v, 32); return v; }
DEVI uint32_t wmaxu(uint32_t v) {
#pragma unroll
  for (int o = 1; o < 64; o <<= 1) { uint32_t t = (uint32_t)__shfl_xor((int)v, o); v = v > t ? v : t; }
  return v;
}
DEVI uint32_t f2sort(float f) { return __float_as_uint(f); }
DEVI float sort2f(uint32_t s) { return __uint_as_float(s); }

typedef __attribute__((ext_vector_type(2))) __bf16 bf16x2_t;
DEVI float dot2bf(uint32_t a, uint32_t b, float acc) { return __builtin_amdgcn_fdot2_f32_bf16(__builtin_bit_cast(bf16x2_t, a), __builtin_bit_cast(bf16x2_t, b), acc, false); }
DEVI int tid_opaque() { int t = threadIdx.x; asm volatile("" : "+v"(t)); return t; }
typedef __attribute__((ext_vector_type(8))) short bf16x8;
typedef __attribute__((ext_vector_type(16))) float f32x16;

union Frag { bf16x8 v; uint32_t u[4]; uint2 d[2]; uint4 q; };
#define CE_DESC(x, y) { const float a_ = __uint_as_float(x), b_ = __uint_as_float(y); (x) = __float_as_uint(__builtin_fmaxf(a_, b_)); (y) = __float_as_uint(__builtin_fminf(a_, b_)); }
DEVI void sort16_desc(uint32_t (&a)[16]) {
#pragma unroll
  for (int k = 2; k <= 16; k <<= 1) {
#pragma unroll
    for (int j = k >> 1; j > 0; j >>= 1) {
#pragma unroll
      for (int i = 0; i < 16; i++) {
        const int l = i ^ j;
        if (l > i) { if ((i & k) == 0) CE_DESC(a[i], a[l]) else CE_DESC(a[l], a[i]) }
      }
    }
  }
}
DEVI void merge16_desc(uint32_t (&x)[16], const uint32_t (&y)[16]) {
#pragma unroll
  for (int i = 0; i < 16; i++) x[i] = __float_as_uint(__builtin_fmaxf(__uint_as_float(x[i]), __uint_as_float(y[15 - i])));
#pragma unroll
  for (int j = 8; j > 0; j >>= 1) {
#pragma unroll
    for (int i = 0; i < 16; i++) {
      const int l = i ^ j;
      if (l > i) CE_DESC(x[i], x[l])
    }
  }
}

DEVI const float* hrow_ptr(const P& p, int prow, bool& zero) {
  const int b = prow / TP, tt = prow - b * TP;
  zero = false;
  if (tt < NMETA) return p.in[1] + (size_t)tt * DM;
  if (tt < NMETA + SEQ) return p.in[0] + ((size_t)b * SEQ + (tt - NMETA)) * DM;
  zero = true; return p.in[0];
}

__device__ void phase_prep(const P& p, int vb, int nvb) {
  const size_t gid = (size_t)vb * 256 + tid_opaque(), gsz = (size_t)nvb * 256;
  char* ws = p.ws;
  {
    uint16_t* o = (uint16_t*)(ws + WS_WT_IN); const float* w = p.in[3]; const float* g = p.in[2];
    for (size_t i = gid; i < (size_t)512 * 1440; i += gsz) {
      const int k = 2 * (int)(i / 1440), n = (int)(i % 1440);
      *(uint32_t*)(o + (size_t)n * 1024 + k) = pk(w[(size_t)k * 1440 + n] * g[k], w[(size_t)(k + 1) * 1440 + n] * g[k + 1]);
    }
    for (size_t i = gid; i < (size_t)96 * 512; i += gsz) *(uint32_t*)(o + (size_t)1440 * 1024 + i * 2) = 0u;
  }
  {
    uint16_t* o = (uint16_t*)(ws + WS_WT_UQ); const float* w = p.in[5]; const float* g = p.in[4];
    for (size_t i = gid; i < (size_t)128 * 768; i += gsz) {
      const int k = 2 * (int)(i / 768), n = (int)(i % 768);
      *(uint32_t*)(o + (size_t)n * 256 + k) = pk(w[(size_t)k * 768 + n] * g[k] * QSCALE, w[(size_t)(k + 1) * 768 + n] * g[k + 1] * QSCALE);
    }
  }
  {
    uint16_t* ok = (uint16_t*)(ws + WS_WT_UK); uint16_t* ov = (uint16_t*)(ws + WS_WT_UV); const float* w = p.in[7]; const float* g = p.in[6];
    for (size_t i = gid; i < (size_t)64 * 1024; i += gsz) {
      const int k = 2 * (int)(i >> 10), c = (int)(i & 1023); const int h = c >> 7, d = c & 127;
      const uint32_t v = pk(w[(size_t)k * 1024 + c] * g[k], w[(size_t)(k + 1) * 1024 + c] * g[k + 1]);
      if (d < 64) *(uint32_t*)(ok + (size_t)(h * 64 + d) * 128 + k) = v; else *(uint32_t*)(ov + (size_t)(h * 64 + d - 64) * 128 + k) = v;
    }
  }
  {
    uint16_t* o = (uint16_t*)(ws + WS_WT_OUT); const float* w = p.in[14]; const float* ga = p.in[12]; const float* gc = p.in[13];
    for (size_t i = gid; i < (size_t)512 * 1024; i += gsz) {
      const int k = 2 * (int)(i >> 10), n = (int)(i & 1023);
      const float g0 = k < 512 ? ga[k] : gc[k - 512], g1 = k < 512 ? ga[k + 1] : gc[k + 1 - 512];
      *(uint32_t*)(o + (size_t)n * 1024 + k) = pk(w[(size_t)k * 1024 + n] * g0, w[(size_t)(k + 1) * 1024 + n] * g1);
    }
  }
  {
    uint16_t* o = (uint16_t*)(ws + WS_WT_PQ); const float* w = p.in[16]; const float* g = p.in[15];
    for (size_t i = gid; i < (size_t)512 * 1024; i += gsz) {
      const int k = 2 * (int)(i >> 10), n = (int)(i & 1023);
      *(uint32_t*)(o + (size_t)n * 1024 + k) = pk(w[(size_t)k * 1024 + n] * g[k], w[(size_t)(k + 1) * 1024 + n] * g[k + 1]);
    }
  }
  {
    uint16_t* o = (uint16_t*)(ws + WS_KEYS); const float* w = p.in[17];
    for (size_t i = gid; i < (size_t)8 * 2 * 128 * 64; i += gsz) o[i] = (uint16_t)f2bf(w[i]);
  }
  {
    float* ct = (float*)(ws + WS_ROPE); float* st = ct + TP * 16;
    for (size_t i = gid; i < (size_t)TP * 16; i += gsz) {
      int pos = (int)(i >> 4), j = (int)(i & 15);
      float fr = powf(10000.0f, -(float)j / 16.0f); float ang = (float)pos * fr;
      ct[i] = cosf(ang); st[i] = sinf(ang);
    }
  }
  {
    uint4* hb = (uint4*)(ws + WS_HB);
    for (size_t i = gid; i < (size_t)NTOK * 128; i += gsz) {
      const int prow = (int)(i >> 7), c = (int)(i & 127);
      bool zf; const float* src = hrow_ptr(p, prow, zf);
      uint4 o = make_uint4(0u, 0u, 0u, 0u);
      if (!zf) { const float4 a = *(const float4*)(src + c * 8), b = *(const float4*)(src + c * 8 + 4); o = make_uint4(pk(a.x, a.y), pk(a.z, a.w), pk(b.x, b.y), pk(b.z, b.w)); }
      hb[i] = o;
    }
  }
}

__device__ void convert_tables(const P& p, int vb, int nvb) {
  const size_t gid = (size_t)vb * 256 + tid_opaque(), gsz = (size_t)nvb * 256;
  char* ws = p.ws;
  {
    const float4* u = (const float4*)p.in[18]; const float4* v = (const float4*)p.in[19];
    uint4* ou = (uint4*)(ws + WS_U8); uint4* ov = (uint4*)(ws + WS_V8);
    for (size_t i = gid; i < (size_t)16384 * 1024 / 16; i += gsz) {
      uint32_t w[4];
#pragma unroll
      for (int q = 0; q < 4; q++) {
        const float4 a = u[i * 4 + q]; int x = 0;
        x = __builtin_amdgcn_cvt_pk_fp8_f32(a.x * USCALE, a.y * USCALE, x, false);
        x = __builtin_amdgcn_cvt_pk_fp8_f32(a.z * USCALE, a.w * USCALE, x, true);
        w[q] = (uint32_t)x;
      }
      ou[i] = make_uint4(w[0], w[1], w[2], w[3]);
#pragma unroll
      for (int q = 0; q < 4; q++) {
        const float4 a = v[i * 4 + q]; int x = 0;
        x = __builtin_amdgcn_cvt_pk_fp8_f32(a.x * VSCALE, a.y * VSCALE, x, false);
        x = __builtin_amdgcn_cvt_pk_fp8_f32(a.z * VSCALE, a.w * VSCALE, x, true);
        w[q] = (uint32_t)x;
      }
      ov[i] = make_uint4(w[0], w[1], w[2], w[3]);
    }
  }
}

template <int AMODE, bool TRANS, bool MID, int K>
DEVI void gemm_core(char* smem, const char* const (&arow)[4], const bool (&azero)[4], const uint16_t* __restrict__ Bt, int n0, int rot, int ktmask = 0xffff, int bm = 1) {
  uint16_t* As = (uint16_t*)(smem + LDS_AS);
  uint16_t* Bs = (uint16_t*)(smem + LDS_BS);
  float* rs = (float*)(smem + LDS_RS);
  float* Ct = (float*)smem;
  const int t = tid_opaque();
  const int kc = t & 7, r0 = t >> 3;
  constexpr int KT = K >> 6;
#if NAIVE_GEMM
  {
    const int ty = t >> 4, tx = t & 15;
    __syncthreads();
    const char** rp = (const char**)(smem + 40960); int* rz = (int*)(smem + 40960 + 1024);
    if (kc == 0) { for (int i = 0; i < 4; i++) { rp[r0 + 32 * i] = arow[i]; rz[r0 + 32 * i] = azero[i] ? 1 : 0; } }
    __syncthreads();
    float c[8][8];
    for (int i = 0; i < 8; i++) for (int j = 0; j < 8; j++) c[i][j] = 0.f;
    float sq[8] = {0, 0, 0, 0, 0, 0, 0, 0};
    const char* myrow[8]; int myz[8];
    for (int i = 0; i < 8; i++) { myrow[i] = rp[ty * 8 + i]; myz[i] = rz[ty * 8 + i]; }
    __syncthreads();
    for (int k = 0; k < K; k++) {
      if (MID && k == 512) {
        if (tx == 0) for (int i = 0; i < 8; i++) rs[ty * 8 + i] = rsqrtf(sq[i] / 512.f + EPS);
        __syncthreads();
        for (int i = 0; i < 8; i++) { float s = rs[ty * 8 + i]; for (int j = 0; j < 8; j++) c[i][j] *= s; }
      }
      float a[8], b[8];
      for (int i = 0; i < 8; i++) {
        float v;
        if (AMODE == 0) v = bf1(((const uint16_t*)myrow[i])[k]);
        else { v = myz[i] ? 0.f : ((const float*)myrow[i])[k]; }
        if (!MID || k < 512) sq[i] += v * v;
        a[i] = bf1((uint16_t)f2bf(v));
      }
      for (int j = 0; j < 8; j++) b[j] = bf1(Bt[(size_t)(n0 + tx * 8 + j) * K + k]);
      for (int i = 0; i < 8; i++) for (int j = 0; j < 8; j++) c[i][j] += a[i] * b[j];
    }
    __syncthreads();
    if (!MID && tx == 0) for (int i = 0; i < 8; i++) rs[ty * 8 + i] = rsqrtf(sq[i] / (float)K + EPS);
    for (int i = 0; i < 8; i++) for (int j = 0; j < 8; j++) {
      if (TRANS) Ct[(tx * 8 + j) * CT_LD + ty * 8 + i] = c[i][j]; else Ct[(ty * 8 + i) * CT_LD + tx * 8 + j] = c[i][j];
    }
    __syncthreads();
    return;
  }
#else
  const int wave = t >> 6, lane = t & 63, wm = wave >> 1, wn = wave & 1, lr = lane & 31, lh = lane >> 5;
  f32x16 acc[2][2];
#pragma unroll
  for (int i = 0; i < 2; i++)
#pragma unroll
    for (int j = 0; j < 2; j++)
#pragma unroll
      for (int r = 0; r < 16; r++) acc[i][j][r] = 0.f;
  uint4 xa00, xa01, xa02, xa03, xa10, xa11, xa12, xa13;
  uint4 xb00, xb01, xb02, xb03, xb10, xb11, xb12, xb13;
  float4 fa00, fa01, fa02, fa03, fa10, fa11, fa12, fa13;
  float4 fb00, fb01, fb02, fb03, fb10, fb11, fb12, fb13;
  float ssq0 = 0.f, ssq1 = 0.f, ssq2 = 0.f, ssq3 = 0.f;
  const float4 zero4 = make_float4(0.f, 0.f, 0.f, 0.f);
  const uint16_t* brow = Bt + (size_t)(n0 + r0 * bm) * K + kc * 8;
#define GL_LD1(i, S)                                                                                             \
  {                                                                                                              \
    if (AMODE == 0) {                                                                                            \
      xa##S##i = *(const uint4*)(arow[i] + ((size_t)kt_ * 64 + kc * 8) * 2);                                     \
    } else {                                                                                                     \
      fa##S##i = zero4; fb##S##i = zero4;                                                                        \
      if (!azero[i]) {                                                                                           \
        const float* src_ = (const float*)(arow[i]) + kt_ * 64 + kc * 8;                                         \
        fa##S##i = *(const float4*)src_; fb##S##i = *(const float4*)(src_ + 4);                                  \
      }                                                                                                          \
    }                                                                                                            \
    xb##S##i = *(const uint4*)(brow + (size_t)(32 * i * bm) * K + kt_ * 64);                                     \
  }
#define GL_LOAD(KT_, S) { int kt_ = MID ? (((KT_) & 8) | (((KT_) + rot) & 7)) : (((KT_) + rot) & (KT - 1)); kt_ &= ktmask; asm volatile("" : "+s"(kt_)); GL_LD1(0, S) GL_LD1(1, S) GL_LD1(2, S) GL_LD1(3, S) }
#define GL_ST1(i, S, BUF_, SSQ)                                                                                  \
  {                                                                                                              \
    uint4 ra_;                                                                                                   \
    if (AMODE == 0) {                                                                                            \
      ra_ = xa##S##i;                                                                                            \
      if (dossq_) {                                                                                              \
        SSQ = dot2bf(ra_.x, ra_.x, SSQ); SSQ = dot2bf(ra_.y, ra_.y, SSQ);                                        \
        SSQ = dot2bf(ra_.z, ra_.z, SSQ); SSQ = dot2bf(ra_.w, ra_.w, SSQ);                                        \
      }                                                                                                          \
    } else {                                                                                                     \
      const float4 f0 = fa##S##i, f1 = fb##S##i;                                                                 \
      if (dossq_) SSQ += f0.x * f0.x + f0.y * f0.y + f0.z * f0.z + f0.w * f0.w + f1.x * f1.x + f1.y * f1.y + f1.z * f1.z + f1.w * f1.w; \
      ra_ = make_uint4(pk(f0.x, f0.y), pk(f0.z, f0.w), pk(f1.x, f1.y), pk(f1.z, f1.w));                          \
    }                                                                                                            \
    *(uint4*)(As + (size_t)(BUF_) * 128 * 72 + (r0 + 32 * i) * 72 + kc * 8) = ra_;                               \
    *(uint4*)(Bs + (size_t)(BUF_) * 128 * 72 + (r0 + 32 * i) * 72 + kc * 8) = xb##S##i;                          \
  }
#define GL_STORE(BUF_, S, DOSSQ_) { const bool dossq_ = (DOSSQ_); GL_ST1(0, S, BUF_, ssq0) GL_ST1(1, S, BUF_, ssq1) GL_ST1(2, S, BUF_, ssq2) GL_ST1(3, S, BUF_, ssq3) }
#define GL_RS1(i, SSQ, DEN_)                                                                                     \
  {                                                                                                              \
    float s_ = SSQ;                                                                                              \
    s_ += __shfl_xor(s_, 1); s_ += __shfl_xor(s_, 2); s_ += __shfl_xor(s_, 4);                                   \
    if (kc == 0) rs[r0 + 32 * i] = rsqrtf(s_ / (DEN_) + EPS);                                                    \
  }
#define GL_RS(DEN_) { GL_RS1(0, ssq0, DEN_) GL_RS1(1, ssq1, DEN_) GL_RS1(2, ssq2, DEN_) GL_RS1(3, ssq3, DEN_) }
#define GL_COMPUTE(BUF_)                                                                                         \
  {                                                                                                              \
    const uint16_t* Ab = As + (size_t)(BUF_) * 128 * 72;                                                         \
    const uint16_t* Bb = Bs + (size_t)(BUF_) * 128 * 72;                                                         \
    _Pragma("unroll") for (int ks = 0; ks < 4; ks++) {                                                           \
      bf16x8 a[2], b[2];                                                                                         \
      _Pragma("unroll") for (int mi = 0; mi < 2; mi++) a[mi] = *(const bf16x8*)(Ab + (64 * wm + 32 * mi + lr) * 72 + 16 * ks + 8 * lh); \
      _Pragma("unroll") for (int ni = 0; ni < 2; ni++) b[ni] = *(const bf16x8*)(Bb + (64 * wn + 32 * ni + lr) * 72 + 16 * ks + 8 * lh); \
      _Pragma("unroll") for (int mi = 0; mi < 2; mi++)                                                           \
        _Pragma("unroll") for (int ni = 0; ni < 2; ni++) {                                                       \
          if (TRANS) acc[mi][ni] = __builtin_amdgcn_mfma_f32_32x32x16_bf16(b[ni], a[mi], acc[mi][ni], 0, 0, 0);  \
          else acc[mi][ni] = __builtin_amdgcn_mfma_f32_32x32x16_bf16(a[mi], b[ni], acc[mi][ni], 0, 0, 0);        \
        }                                                                                                        \
      if (ks == 1) __builtin_amdgcn_sched_barrier(0);                                                            \
    }                                                                                                            \
  }
  __syncthreads();
  GL_LOAD(0, 0);
  GL_LOAD(1, 1);
  GL_STORE(0, 0, true);
  __syncthreads();
  if (KT <= 4) {
    if (KT > 2) GL_LOAD(2, 0);
#pragma unroll
    for (int kt = 0; kt < KT; kt += 2) {
      GL_COMPUTE(0);
      GL_STORE(1, 1, true);
      if (kt + 3 < KT) GL_LOAD(kt + 3, 1);
      __syncthreads();
      GL_COMPUTE(1);
      if (kt + 2 < KT) {
        GL_STORE(0, 0, true);
        if (kt + 4 < KT) GL_LOAD(kt + 4, 0);
      }
      __syncthreads();
    }
  } else {
    GL_LOAD(2, 0);
#pragma unroll 1
    for (int kt = 0; kt < KT; kt += 2) {
      if (MID && kt == 8) {
        GL_RS(512.f);
        __syncthreads();
#pragma unroll
        for (int mi = 0; mi < 2; mi++) {
          f32x16 sv;
#pragma unroll
          for (int r = 0; r < 16; r++) sv[r] = rs[64 * wm + 32 * mi + (r & 3) + 8 * (r >> 2) + 4 * lh];
          acc[mi][0] *= sv; acc[mi][1] *= sv;
        }
      }
      GL_COMPUTE(0);
      GL_STORE(1, 1, !MID || (kt + 1) < 8);
      GL_LOAD((kt + 3 < KT ? kt + 3 : KT - 1), 1);
      __syncthreads();
      GL_COMPUTE(1);
      GL_STORE(0, 0, (kt + 2 < KT) && (!MID || (kt + 2) < 8));
      GL_LOAD((kt + 4 < KT ? kt + 4 : KT - 1), 0);
      __syncthreads();
    }
  }
  if (!MID) GL_RS((float)K);
#pragma unroll
  for (int mi = 0; mi < 2; mi++)
#pragma unroll
    for (int ni = 0; ni < 2; ni++)
#pragma unroll
      for (int r = 0; r < 16; r++) {
        const int ri = (r & 3) + 8 * (r >> 2) + 4 * lh;
        if (TRANS) Ct[(64 * wn + 32 * ni + ri) * CT_LD + 64 * wm + 32 * mi + lr] = acc[mi][ni][r];
        else Ct[(64 * wm + 32 * mi + ri) * CT_LD + 64 * wn + 32 * ni + lr] = acc[mi][ni][r];
      }
  __syncthreads();
#endif
}

__device__ void phase_gemm_z(const P& p, int vb, int nvb, char* smem) {
  const int t = tid_opaque(), kc = t & 7, r0 = t >> 3;
  const float* Ct = (const float*)smem; const float* rs = (const float*)(smem + LDS_RS);
  uint16_t* z = (uint16_t*)(p.ws + WS_Z); uint16_t* krope = (uint16_t*)(p.ws + WS_KROPE);
  const float* cost = (const float*)(p.ws + WS_ROPE); const float* sint = cost + TP * 16;
  const bool xs = (nvb & 7) == 0;
  const int xcd = vb & 7, slot = vb >> 3, nslot = nvb >> 3;
  for (int li = xs ? slot : vb; li < (xs ? 33 * 12 : 264 * 12); li += (xs ? nslot : nvb)) {
    const int mt = xs ? (li / 12) * 8 + xcd : li / 12, nt = li % 12;
    const char* arow[4]; const bool az[4] = {false, false, false, false};
#pragma unroll
    for (int i = 0; i < 4; i++) arow[i] = p.ws + WS_HB + (size_t)(mt * 128 + r0 + 32 * i) * 2048;
    gemm_core<0, false, false, 1024>(smem, arow, az, (const uint16_t*)(p.ws + WS_WT_IN), nt * 128, (nt * 4) / 3);
    const int c8 = t & 15;
    if (nt < 11) {
#pragma unroll
      for (int i = 0; i < 8; i++) {
        const int r = (t >> 4) + 16 * i; const float s = rs[r];
        const float4 v0 = *(const float4*)(Ct + r * CT_LD + c8 * 8), v1 = *(const float4*)(Ct + r * CT_LD + c8 * 8 + 4);
        uint4 o = make_uint4(pk(v0.x * s, v0.y * s), pk(v0.z * s, v0.w * s), pk(v1.x * s, v1.y * s), pk(v1.z * s, v1.w * s));
        *(uint4*)(z + (size_t)(mt * 128 + r) * ZW + nt * 128 + c8 * 8) = o;
      }
    } else if (c8 < 2) {
#pragma unroll
      for (int i = 0; i < 8; i++) {
        const int r = (t >> 4) + 16 * i; const float s = rs[r];
        const int prow = mt * 128 + r; const int pos = prow % TP;
        float o1[8], o2[8];
#pragma unroll
        for (int e = 0; e < 8; e++) {
          const int c = c8 * 8 + e;
          const float x1 = Ct[r * CT_LD + c] * s, x2 = Ct[r * CT_LD + c + 16] * s;
          const float cs = cost[pos * 16 + c], sn = sint[pos * 16 + c];
          o1[e] = x1 * cs - x2 * sn; o2[e] = x2 * cs + x1 * sn;
        }
        *(uint4*)(krope + (size_t)prow * 32 + c8 * 8) = make_uint4(pk(o1[0], o1[1]), pk(o1[2], o1[3]), pk(o1[4], o1[5]), pk(o1[6], o1[7]));
        *(uint4*)(krope + (size_t)prow * 32 + 16 + c8 * 8) = make_uint4(pk(o2[0], o2[1]), pk(o2[2], o2[3]), pk(o2[4], o2[5]), pk(o2[6], o2[7]));
      }
    }
  }
}

DEVI float fast_sigmoid(float x) { return __builtin_amdgcn_rcpf(1.f + __expf(-x)); }
__device__ void phase_conv(const P& p, int vb, int nvb, char* smem) {
  constexpr int CT = 24, NTL = 171;
  uint32_t* E0 = (uint32_t*)smem;
  uint32_t* E1 = E0 + 28 * 256;
  float* cv = (float*)smem;
  const int t = tid_opaque(), wave = t >> 6, lane = t & 63;
  const uint16_t* z = (const uint16_t*)(p.ws + WS_Z);
  uint16_t* mixed = (uint16_t*)(p.ws + WS_MIXED);
  const float* cw = p.in[8]; const float* cb = p.in[9]; const float* gl = p.in[10]; const float* bl = p.in[11];
  uint32_t wp0[16], wp1[16];
#pragma unroll
  for (int jp = 0; jp < 16; jp++) {
    const float2 wa = *(const float2*)(cw + (2 * jp) * 512 + 2 * t);
    float2 wb = make_float2(0.f, 0.f);
    if (jp < 15) wb = *(const float2*)(cw + (2 * jp + 1) * 512 + 2 * t);
    wp0[jp] = pk(wa.x, wb.x); wp1[jp] = pk(wa.y, wb.y);
  }
  const float bias0 = cb[2 * t], bias1 = cb[2 * t + 1];
  for (int tile = vb; tile < NBATCH * NTL; tile += nvb) {
    const int b = tile / NTL, t0 = NMETA + (tile - b * NTL) * CT;
    __syncthreads();
#pragma unroll 1
    for (int kb = 0; kb < 27; kb += 9) {
      uint32_t a2[18], b2[18];
#pragma unroll
      for (int u = 0; u < 18; u++) {
        const int tt = t0 - 30 + 2 * kb + u;
        const uint16_t* zr = z + (size_t)(b * TP + (tt < 0 ? 0 : tt)) * ZW;
        a2[u] = *(const uint32_t*)(zr + 2 * t); b2[u] = *(const uint32_t*)(zr + 512 + 2 * t);
      }
#pragma unroll
      for (int u = 0; u < 9; u++) {
        const int tt = t0 - 30 + 2 * (kb + u);
        float h00 = bflo(a2[2 * u]) * fast_sigmoid(bflo(b2[2 * u])), h01 = bfhi(a2[2 * u]) * fast_sigmoid(bfhi(b2[2 * u]));
        float h10 = bflo(a2[2 * u + 1]) * fast_sigmoid(bflo(b2[2 * u + 1])), h11 = bfhi(a2[2 * u + 1]) * fast_sigmoid(bfhi(b2[2 * u + 1]));
        if (tt < 0) { h00 = 0.f; h01 = 0.f; }
        if (tt + 1 < 0) { h10 = 0.f; h11 = 0.f; }
        E0[(kb + u) * 256 + t] = pk(h00, h10);
        E1[(kb + u) * 256 + t] = pk(h01, h11);
      }
    }
    E0[27 * 256 + t] = 0u; E1[27 * 256 + t] = 0u;
    float acc0[CT], acc1[CT];
#pragma unroll
    for (int ip = 0; ip < CT / 2; ip++) {
      float e0 = bias0, o0 = bias0, e1 = bias1, o1 = bias1;
      uint32_t pv0 = E0[ip * 256 + t], pv1 = E1[ip * 256 + t];
#pragma unroll
      for (int jp = 0; jp < 16; jp++) {
        const uint32_t nx0 = E0[(ip + jp + 1) * 256 + t], nx1 = E1[(ip + jp + 1) * 256 + t];
        e0 = dot2bf(pv0, wp0[jp], e0); e1 = dot2bf(pv1, wp1[jp], e1);
        o0 = dot2bf(__builtin_amdgcn_alignbyte(nx0, pv0, 2), wp0[jp], o0);
        o1 = dot2bf(__builtin_amdgcn_alignbyte(nx1, pv1, 2), wp1[jp], o1);
        pv0 = nx0; pv1 = nx1;
      }
      acc0[2 * ip] = e0; acc0[2 * ip + 1] = o0; acc1[2 * ip] = e1; acc1[2 * ip + 1] = o1;
    }
    __syncthreads();
#pragma unroll
    for (int i = 0; i < CT; i++) *(float2*)(cv + i * 512 + 2 * t) = make_float2(acc0[i], acc1[i]);
    __syncthreads();
    float gln[8], bln[8];
#pragma unroll
    for (int e = 0; e < 8; e++) { gln[e] = gl[lane * 8 + e]; bln[e] = bl[lane * 8 + e]; }
#pragma unroll 2
    for (int q = 0; q < CT / 4; q++) {
      const int tk = wave * (CT / 4) + q;
      float v[8];
      const float4 x0 = *(const float4*)(cv + tk * 512 + lane * 8), x1 = *(const float4*)(cv + tk * 512 + lane * 8 + 4);
      v[0] = x0.x; v[1] = x0.y; v[2] = x0.z; v[3] = x0.w; v[4] = x1.x; v[5] = x1.y; v[6] = x1.z; v[7] = x1.w;
      float s = 0.f;
#pragma unroll
      for (int e = 0; e < 8; e++) s += v[e];
      const float mu = wsum64(s) * (1.f / 512.f);
      float s2 = 0.f;
#pragma unroll
      for (int e = 0; e < 8; e++) { v[e] -= mu; s2 += v[e] * v[e]; }
      const float rstd = rsqrtf(wsum64(s2) * (1.f / 512.f) + EPS);
      float s3 = 0.f;
#pragma unroll
      for (int e = 0; e < 8; e++) {
        const float y = v[e] * rstd * gln[e] + bln[e];
        const float sl = y * fast_sigmoid(y);
        v[e] = sl; s3 += sl * sl;
      }
      const float r2 = rsqrtf(wsum64(s3) * (1.f / 512.f) + EPS);
      uint4 o = make_uint4(pk(v[0] * r2, v[1] * r2), pk(v[2] * r2, v[3] * r2), pk(v[4] * r2, v[5] * r2), pk(v[6] * r2, v[7] * r2));
      *(uint4*)(mixed + (size_t)(b * TP + t0 + tk) * 1024 + 512 + lane * 8) = o;
    }
  }
}

__device__ void phase_gemm_qkv(const P& p, int vb, int nvb, char* smem) {
  const int t = tid_opaque(), kc = t & 7, r0 = t >> 3;
  const float* Ct = (const float*)smem; const float* rs = (const float*)(smem + LDS_RS);
  const uint16_t* z = (const uint16_t*)(p.ws + WS_Z);
  uint16_t* Q = (uint16_t*)(p.ws + WS_Q); uint16_t* Kn = (uint16_t*)(p.ws + WS_KN); uint16_t* Vt = (uint16_t*)(p.ws + WS_VT);
  const float* cost = (const float*)(p.ws + WS_ROPE); const float* sint = cost + TP * 16;
  const bool az[4] = {false, false, false, false};
  for (int tile = vb; tile < 264 * 14; tile += nvb) {
    const int mt = tile / 14, nt = tile - mt * 14;
    const char* arow[4];
    if (nt < 6) {
#pragma unroll
      for (int i = 0; i < 4; i++) arow[i] = (const char*)(z + (size_t)(mt * 128 + r0 + 32 * i) * ZW + 1024);
      gemm_core<0, false, false, 256>(smem, arow, az, (const uint16_t*)(p.ws + WS_WT_UQ), nt * 128, nt);
      int te = threadIdx.x; asm volatile("" : "+v"(te)); const int c8 = te & 15, tq = te >> 4;
      const int gc = nt * 128 + c8 * 8; const int hd = gc / 96; const int d = gc - hd * 96;
#pragma unroll
      for (int i = 0; i < 8; i++) {
        const int r = tq + 16 * i; const float s = rs[r]; const int prow = mt * 128 + r;
        if (d < 64) {
          const float4 v0 = *(const float4*)(Ct + r * CT_LD + c8 * 8), v1 = *(const float4*)(Ct + r * CT_LD + c8 * 8 + 4);
          *(uint4*)(Q + (size_t)prow * 768 + gc) = make_uint4(pk(v0.x * s, v0.y * s), pk(v0.z * s, v0.w * s), pk(v1.x * s, v1.y * s), pk(v1.z * s, v1.w * s));
        } else if (d < 80) {
          const int pos = prow % TP; float o1[8], o2[8];
#pragma unroll
          for (int e = 0; e < 8; e++) {
            const int c = c8 * 8 + e; const int j = d - 64 + e;
            const float x1 = Ct[r * CT_LD + c] * s, x2 = Ct[r * CT_LD + c + 16] * s;
            const float cs = cost[pos * 16 + j], sn = sint[pos * 16 + j];
            o1[e] = x1 * cs - x2 * sn; o2[e] = x2 * cs + x1 * sn;
          }
          *(uint4*)(Q + (size_t)prow * 768 + gc) = make_uint4(pk(o1[0], o1[1]), pk(o1[2], o1[3]), pk(o1[4], o1[5]), pk(o1[6], o1[7]));
          *(uint4*)(Q + (size_t)prow * 768 + gc + 16) = make_uint4(pk(o2[0], o2[1]), pk(o2[2], o2[3]), pk(o2[4], o2[5]), pk(o2[6], o2[7]));
        }
      }
    } else if (nt < 10) {
      const int n0 = (nt - 6) * 128;
#pragma unroll
      for (int i = 0; i < 4; i++) arow[i] = (const char*)(z + (size_t)(mt * 128 + r0 + 32 * i) * ZW + 1280);
      gemm_core<0, false, false, 128>(smem, arow, az, (const uint16_t*)(p.ws + WS_WT_UK), n0, nt);
      int te = threadIdx.x; asm volatile("" : "+v"(te)); const int c8 = te & 15, tq = te >> 4;
#pragma unroll
      for (int i = 0; i < 8; i++) {
        const int r = tq + 16 * i; const float s = rs[r]; const int prow = mt * 128 + r;
        const float4 v0 = *(const float4*)(Ct + r * CT_LD + c8 * 8), v1 = *(const float4*)(Ct + r * CT_LD + c8 * 8 + 4);
        *(uint4*)(Kn + (size_t)prow * 512 + n0 + c8 * 8) = make_uint4(pk(v0.x * s, v0.y * s), pk(v0.z * s, v0.w * s), pk(v1.x * s, v1.y * s), pk(v1.z * s, v1.w * s));
      }
    } else {
      const int n0 = (nt - 10) * 128;
#pragma unroll
      for (int i = 0; i < 4; i++) arow[i] = (const char*)(z + (size_t)(mt * 128 + r0 + 32 * i) * ZW + 1280);
      gemm_core<0, true, false, 128>(smem, arow, az, (const uint16_t*)(p.ws + WS_WT_UV), n0, nt);
      int te = threadIdx.x; asm volatile("" : "+v"(te)); const int c8 = te & 15, tq = te >> 4;
      const int b = (mt * 128) / TP; const int tt0 = mt * 128 - b * TP;
      float sc[8];
#pragma unroll
      for (int e = 0; e < 8; e++) sc[e] = rs[c8 * 8 + e];
#pragma unroll
      for (int i = 0; i < 8; i++) {
        const int r = tq + 16 * i;
        const int n = n0 + r; const int hd = n >> 6, dv = n & 63;
        const float4 v0 = *(const float4*)(Ct + r * CT_LD + c8 * 8), v1 = *(const float4*)(Ct + r * CT_LD + c8 * 8 + 4);
        *(uint4*)(Vt + ((size_t)((b * 8 + hd) * 64 + dv)) * TP + tt0 + c8 * 8) =
            make_uint4(pk(v0.x * sc[0], v0.y * sc[1]), pk(v0.z * sc[2], v0.w * sc[3]), pk(v1.x * sc[4], v1.y * sc[5]), pk(v1.z * sc[6], v1.w * sc[7]));
      }
    }
  }
}

#if NAIVE_ATTN
__device__ void phase_attn(const P& p, int vb, int nvb, char* smem) {
  const uint16_t* Q = (const uint16_t*)(p.ws + WS_Q); const uint16_t* Kn = (const uint16_t*)(p.ws + WS_KN);
  const uint16_t* Vt = (const uint16_t*)(p.ws + WS_VT); const uint16_t* kr = (const uint16_t*)(p.ws + WS_KROPE);
  uint16_t* mixed = (uint16_t*)(p.ws + WS_MIXED);
  for (int item = vb; item < 64 * 17; item += nvb) {
    const int bh = item / 17, qc = item - bh * 17; const int b = bh >> 3, h = bh & 7;
    const int q = qc * 256 + threadIdx.x;
    const bool valid = q < TP; const int qq = valid ? q : TP - 1;
    float qv[96];
#pragma unroll
    for (int d = 0; d < 96; d++) qv[d] = bf1(Q[(size_t)(b * TP + qq) * 768 + h * 96 + d]);
    float o[64];
#pragma unroll
    for (int d = 0; d < 64; d++) o[d] = 0.f;
    float m = -INFINITY, l = 0.f;
    int kmax = qc * 256 + 255; if (kmax > TP - 1) kmax = TP - 1;
    for (int j = 0; j <= kmax; j++) {
      const uint16_t* kp = Kn + (size_t)(b * TP + j) * 512 + h * 64;
      const uint16_t* rp = kr + (size_t)(b * TP + j) * 32;
      float s = 0.f;
#pragma unroll
      for (int d = 0; d < 64; d++) s += qv[d] * bf1(kp[d]);
#pragma unroll
      for (int d = 0; d < 32; d++) s += qv[64 + d] * bf1(rp[d]);
      if (j > qq) s = -INFINITY;
      const float mn = fmaxf(m, s);
      const float alpha = exp2f(m - mn), pj = exp2f(s - mn);
      m = mn; l = l * alpha + pj;
      const uint16_t* vp = Vt + (size_t)((b * 8 + h) * 64) * TP + j;
#pragma unroll
      for (int d = 0; d < 64; d++) o[d] = o[d] * alpha + pj * bf1(vp[(size_t)d * TP]);
    }
    if (valid) {
      const float inv = 1.f / l;
      uint16_t* op = mixed + (size_t)(b * TP + q) * 1024 + h * 64;
#pragma unroll
      for (int d = 0; d < 64; d += 2) *(uint32_t*)(op + d) = pk(o[d] * inv, o[d + 1] * inv);
    }
  }
}
#endif

#if !NAIVE_ATTN
__device__ void phase_attn(const P& p, int vb, int nvb, char* smem) {
  const int t = tid_opaque(), wave = t >> 6, lane = t & 63, lr = lane & 31, lh = lane >> 5;
  const uint16_t* Q = (const uint16_t*)(p.ws + WS_Q); const uint16_t* Kn = (const uint16_t*)(p.ws + WS_KN);
  const uint16_t* Vt = (const uint16_t*)(p.ws + WS_VT); const uint16_t* kr = (const uint16_t*)(p.ws + WS_KROPE);
  uint16_t* mixed = (uint16_t*)(p.ws + WS_MIXED);
  constexpr int KP = 104, VP = 68;
  constexpr int KBYTES = 64 * KP * 2, BUFB = KBYTES + 64 * VP * 2;
  constexpr int NITEM = 64 * 33;
  if (vb & 1) convert_tables(p, vb, nvb);
  for (int rnd = 0; rnd * nvb < NITEM; rnd++) {
    const int it = (rnd & 1) ? rnd * nvb + (nvb - 1 - vb) : rnd * nvb + vb;
    if (it >= NITEM) continue;
    const int qb = 32 - (it >> 6), bh = it & 63, b = bh >> 3, h = bh & 7;
    const int q0 = qb * 128, nkt = 2 * qb + 2;
    const int qlo = q0 + 32 * wave, qrow = qlo + lr;
    const bool wreal = qlo < NMETA + SEQ;
    Frag qf[6];
#pragma unroll
    for (int s = 0; s < 6; s++) qf[s].q = *(const uint4*)(Q + (size_t)(b * TP + qrow) * 768 + h * 96 + 16 * s + 8 * lh);
    f32x16 o0, o1;
#pragma unroll
    for (int r = 0; r < 16; r++) { o0[r] = 0.f; o1[r] = 0.f; }
    float m = -INFINITY, l = 0.f;
    uint4 st0, st1, st2, st3, st4;
    const uint16_t* kbase = Kn + (size_t)(b * TP + (t >> 3)) * 512 + h * 64 + (t & 7) * 8;
    const uint16_t* rbase = kr + (size_t)(b * TP + (t >> 2)) * 32 + (t & 3) * 8;
    const uint16_t* vbase = Vt + ((size_t)((b * 8 + h) * 64 + (t >> 3))) * TP + (t & 7) * 8;
#define AT_LOAD(KT_)                                                    \
  {                                                                     \
    const int k0_ = (KT_) * 64;                                         \
    st0 = *(const uint4*)(kbase + (size_t)k0_ * 512);                   \
    st1 = *(const uint4*)(kbase + (size_t)(k0_ + 32) * 512);            \
    st2 = *(const uint4*)(rbase + (size_t)k0_ * 32);                    \
    st3 = *(const uint4*)(vbase + k0_);                                 \
    st4 = *(const uint4*)(vbase + (size_t)32 * TP + k0_);               \
  }
#define AT_STORE(BUF_)                                                                    \
  {                                                                                       \
    char* kl_ = smem + (BUF_) * BUFB; char* vl_ = kl_ + KBYTES;                           \
    *(uint4*)(kl_ + ((t >> 3) * KP + (t & 7) * 8) * 2) = st0;                             \
    *(uint4*)(kl_ + (((t >> 3) + 32) * KP + (t & 7) * 8) * 2) = st1;                      \
    *(uint4*)(kl_ + ((t >> 2) * KP + 64 + (t & 3) * 8) * 2) = st2;                        \
    *(uint4*)(vl_ + ((t >> 3) * VP + (t & 7) * 8) * 2) = st3;                             \
    *(uint4*)(vl_ + (((t >> 3) + 32) * VP + (t & 7) * 8) * 2) = st4;                      \
  }
    __syncthreads();
    AT_LOAD(0);
    AT_STORE(0);
    __syncthreads();
    for (int kt = 0; kt < nkt; kt++) {
      const int buf = kt & 1;
      if (kt + 1 < nkt) AT_LOAD(kt + 1);
      const int k0 = kt * 64;
      if (wreal && k0 <= qlo + 31) {
        const char* kl = smem + buf * BUFB; const char* vl = kl + KBYTES;
        f32x16 s0, s1;
#pragma unroll
        for (int r = 0; r < 16; r++) { s0[r] = 0.f; s1[r] = 0.f; }
#pragma unroll
        for (int s = 0; s < 6; s++) {
          const bf16x8 k0f = *(const bf16x8*)(kl + ((lr)*KP + 16 * s + 8 * lh) * 2);
          const bf16x8 k1f = *(const bf16x8*)(kl + ((32 + lr) * KP + 16 * s + 8 * lh) * 2);
          s0 = __builtin_amdgcn_mfma_f32_32x32x16_bf16(k0f, qf[s].v, s0, 0, 0, 0);
          s1 = __builtin_amdgcn_mfma_f32_32x32x16_bf16(k1f, qf[s].v, s1, 0, 0, 0);
        }
        if (k0 + 63 > qlo) {
#pragma unroll
          for (int r = 0; r < 16; r++) {
            const int key = k0 + (r & 3) + 8 * (r >> 2) + 4 * lh;
            if (key > qrow) s0[r] = -INFINITY;
            if (key + 32 > qrow) s1[r] = -INFINITY;
          }
        }
        float mx = fmaxf(s0[0], s1[0]);
#pragma unroll
        for (int r = 1; r < 16; r++) mx = fmaxf(mx, fmaxf(s0[r], s1[r]));
        mx = fmaxf(mx, __shfl_xor(mx, 32));
        const float mn = fmaxf(m, mx);
        const float alpha = __builtin_amdgcn_exp2f(m - mn);
        m = mn;
        float psum = 0.f;
#pragma unroll
        for (int r = 0; r < 16; r++) {
          s0[r] = __builtin_amdgcn_exp2f(s0[r] - mn); s1[r] = __builtin_amdgcn_exp2f(s1[r] - mn);
          psum += s0[r] + s1[r];
        }
        l = l * alpha + psum;
        o0 *= alpha; o1 *= alpha;
#pragma unroll
        for (int kk = 0; kk < 2; kk++)
#pragma unroll
          for (int s2 = 0; s2 < 2; s2++) {
            Frag pf;
#pragma unroll
            for (int e = 0; e < 4; e++) pf.u[e] = kk == 0 ? pk(s0[8 * s2 + 2 * e], s0[8 * s2 + 2 * e + 1]) : pk(s1[8 * s2 + 2 * e], s1[8 * s2 + 2 * e + 1]);
            Frag v0f, v1f;
            const char* vp0 = vl + ((lr)*VP + 32 * kk + 16 * s2 + 4 * lh) * 2;
            const char* vp1 = vl + ((32 + lr) * VP + 32 * kk + 16 * s2 + 4 * lh) * 2;
            v0f.d[0] = *(const uint2*)vp0; v0f.d[1] = *(const uint2*)(vp0 + 16);
            v1f.d[0] = *(const uint2*)vp1; v1f.d[1] = *(const uint2*)(vp1 + 16);
            o0 = __builtin_amdgcn_mfma_f32_32x32x16_bf16(v0f.v, pf.v, o0, 0, 0, 0);
            o1 = __builtin_amdgcn_mfma_f32_32x32x16_bf16(v1f.v, pf.v, o1, 0, 0, 0);
          }
      }
      if (kt + 1 < nkt) AT_STORE(buf ^ 1);
      __syncthreads();
    }
    if (wreal) {
      const float lt = l + __shfl_xor(l, 32);
      const float inv = 1.f / lt;
      uint16_t* op = mixed + (size_t)(b * TP + qrow) * 1024 + h * 64 + 4 * lh;
#pragma unroll
      for (int rg = 0; rg < 4; rg++) {
        *(uint2*)(op + 8 * rg) = make_uint2(pk(o0[4 * rg] * inv, o0[4 * rg + 1] * inv), pk(o0[4 * rg + 2] * inv, o0[4 * rg + 3] * inv));
        *(uint2*)(op + 32 + 8 * rg) = make_uint2(pk(o1[4 * rg] * inv, o1[4 * rg + 1] * inv), pk(o1[4 * rg + 2] * inv, o1[4 * rg + 3] * inv));
      }
    }
  }
  if (!(vb & 1)) convert_tables(p, vb, nvb);
}
#endif

DEVI int prow_of(int rr) { return (rr >> 12) * TP + NMETA + (rr & 4095); }

__device__ void phase_gemm_out(const P& p, int vb, int nvb, char* smem, int var = 0) {
  const int t = tid_opaque(), r0 = t >> 3, c8 = t & 15;
  const float* Ct = (const float*)smem;
  const uint16_t* mixed = (const uint16_t*)(p.ws + WS_MIXED);
  float* h2 = (float*)(p.ws + WS_H2);
  const bool az[4] = {false, false, false, false};
  const bool xs = (nvb & 7) == 0;
  const int xcd = vb & 7, slot = vb >> 3, nslot = nvb >> 3;
  for (int li = xs ? slot : vb; li < (xs ? 32 * 8 : 256 * 8); li += (xs ? nslot : nvb)) {
    const int mt = xs ? (li >> 3) * 8 + xcd : li >> 3, nt = li & 7;
    const char* arow[4];
#pragma unroll
    for (int i = 0; i < 4; i++) arow[i] = (const char*)(mixed + (size_t)prow_of(mt * 128 + (var == 3 ? 0 : r0 + 32 * i)) * 1024);
    gemm_core<0, false, true, 1024>(smem, arow, az, (const uint16_t*)(p.ws + WS_WT_OUT), nt * 128, nt, var >= 2 ? 0 : 0xffff, var == 3 ? 0 : 1);
    if (var != 0) continue;
#pragma unroll
    for (int i = 0; i < 8; i++) {
      const int r = (t >> 4) + 16 * i; const int rr = mt * 128 + r;
      const float* xr = p.in[0] + (size_t)rr * DM + nt * 128 + c8 * 8;
      const float4 x0 = *(const float4*)xr, x1 = *(const float4*)(xr + 4);
      const float4 v0 = *(const float4*)(Ct + r * CT_LD + c8 * 8), v1 = *(const float4*)(Ct + r * CT_LD + c8 * 8 + 4);
      const float4 y0 = make_float4(x0.x + v0.x, x0.y + v0.y, x0.z + v0.z, x0.w + v0.w);
      const float4 y1 = make_float4(x1.x + v1.x, x1.y + v1.y, x1.z + v1.z, x1.w + v1.w);
      *(uint4*)(p.ws + WS_HB + ((size_t)rr * DM + nt * 128 + c8 * 8) * 2) = make_uint4(pk(y0.x, y0.y), pk(y0.z, y0.w), pk(y1.x, y1.y), pk(y1.z, y1.w));
      if (i & 1) __builtin_amdgcn_sched_barrier(0);
    }
  }
}

__device__ void phase_peer_q(const P& p, int vb, int nvb, char* smem) {
  const int t = tid_opaque(), r0 = t >> 3, wave = t >> 6, lane = t & 63, lr = lane & 31, lh = lane >> 5;
  float* Ct = (float*)smem; const float* rs = (const float*)(smem + LDS_RS);
  const float* h2 = (const float*)(p.ws + WS_H2);
  const uint16_t* keys = (const uint16_t*)(p.ws + WS_KEYS);
  int* seli = (int*)(p.ws + WS_SELI); float* selg = (float*)(p.ws + WS_SELG);
  const bool az[4] = {false, false, false, false};
  const bool xs = (nvb & 7) == 0;
  const int xcd = vb & 7, slot = vb >> 3, nslot = nvb >> 3;
  for (int li = xs ? slot : vb; li < (xs ? 32 * 8 : 256 * 8); li += (xs ? nslot : nvb)) {
    const int mt = xs ? (li >> 3) * 8 + xcd : li >> 3, hd = li & 7;
    const char* arow[4];
#pragma unroll
    for (int i = 0; i < 4; i++) arow[i] = p.ws + WS_HB + (size_t)(mt * 128 + r0 + 32 * i) * 2048;
    gemm_core<0, false, false, 1024>(smem, arow, az, (const uint16_t*)(p.ws + WS_WT_PQ), hd * 128, hd * 2);
    const int t2 = tid_opaque();
    const int wave2 = t2 >> 6, lr2 = t2 & 31, lh2 = (t2 >> 5) & 1;
    {
      const int r = t2 >> 1, c0 = (t2 & 1) * 64; const float rsv = rs[r];
      float4 tmp[16];
#pragma unroll
      for (int c = 0; c < 16; c++) tmp[c] = *(const float4*)(Ct + r * CT_LD + c0 + c * 4);
      __syncthreads();
      uint32_t* qrow = (uint32_t*)(smem + r * 272 + c0 * 2);
#pragma unroll
      for (int c = 0; c < 16; c++) { qrow[c * 2] = pk(tmp[c].x * rsv, tmp[c].y * rsv); qrow[c * 2 + 1] = pk(tmp[c].z * rsv, tmp[c].w * rsv); }
      __syncthreads();
    }
    uint32_t* svl = (uint32_t*)(smem + 34816);
    {
      const int tk = wave2 * 32 + lr2; const int rr = mt * 128 + tk;
      uint32_t sv0[16], sv1[16];
#pragma unroll 1
      for (int pp = 0; pp < 2; pp++) {
        f32x16 sc[4];
#pragma unroll
        for (int nt = 0; nt < 4; nt++)
#pragma unroll
          for (int r = 0; r < 16; r++) sc[nt][r] = 0.f;
#pragma unroll
        for (int ks = 0; ks < 4; ks++) {
          Frag qfr; qfr.q = *(const uint4*)(smem + tk * 272 + (pp * 64 + 16 * ks + 8 * lh2) * 2);
#pragma unroll
          for (int nt = 0; nt < 4; nt++) {
            Frag kf; kf.q = *(const uint4*)(keys + ((size_t)((hd * 2 + pp) * 128 + 32 * nt + lr2)) * 64 + 16 * ks + 8 * lh2);
            sc[nt] = __builtin_amdgcn_mfma_f32_32x32x16_bf16(kf.v, qfr.v, sc[nt], 0, 0, 0);
          }
          if (ks & 1) __builtin_amdgcn_sched_barrier(0);
        }
        uint32_t g0[16], g1[16], g2[16], g3[16];
#pragma unroll
        for (int r = 0; r < 16; r++) {
          const uint32_t n = (uint32_t)((r & 3) + 8 * (r >> 2) + 4 * lh2);
          g0[r] = (f2sort(sc[0][r]) & ~127u) | n;
          g1[r] = (f2sort(sc[1][r]) & ~127u) | (n + 32u);
          g2[r] = (f2sort(sc[2][r]) & ~127u) | (n + 64u);
          g3[r] = (f2sort(sc[3][r]) & ~127u) | (n + 96u);
        }
        __builtin_amdgcn_sched_barrier(0);
        sort16_desc(g0); sort16_desc(g1);
        __builtin_amdgcn_sched_barrier(0);
        sort16_desc(g2); sort16_desc(g3);
        __builtin_amdgcn_sched_barrier(0);
        merge16_desc(g0, g1); merge16_desc(g2, g3); merge16_desc(g0, g2);
        uint32_t y[16];
#pragma unroll
        for (int e = 0; e < 16; e++) y[e] = (uint32_t)__shfl_xor((int)g0[e], 32);
        merge16_desc(g0, y);
        {
          uint32_t* dst = svl + tk * 32 + pp * 16;
#pragma unroll
          for (int e = 0; e < 16; e += 4) *(uint4*)(dst + e) = make_uint4(g0[e], g0[e + 1], g0[e + 2], g0[e + 3]);
        }
      }
      asm volatile("s_waitcnt lgkmcnt(0)" ::: "memory");
#pragma unroll
      for (int e = 0; e < 16; e += 4) {
        const uint4 a0 = *(const uint4*)(svl + tk * 32 + e), a1 = *(const uint4*)(svl + tk * 32 + 16 + e);
        sv0[e] = a0.x; sv0[e + 1] = a0.y; sv0[e + 2] = a0.z; sv0[e + 3] = a0.w;
        sv1[e] = a1.x; sv1[e + 1] = a1.y; sv1[e + 2] = a1.z; sv1[e + 3] = a1.w;
      }
      __builtin_amdgcn_sched_barrier(0);
      float f0[16], f1[16];
#pragma unroll
      for (int e = 0; e < 16; e++) { f0[e] = sort2f(sv0[e] & ~127u); f1[e] = sort2f(sv1[e] & ~127u); }
      uint32_t c[32];
#define CPK(V_, C_) ((f2sort(V_) & ~255u) | (C_))
      c[0] = lh2 ? CPK(f0[2] + f1[1], 33u) : CPK(f0[0] + f1[0], 0u);
      c[1] = lh2 ? CPK(f0[2] + f1[2], 34u) : CPK(f0[0] + f1[1], 1u);
      c[2] = lh2 ? CPK(f0[2] + f1[3], 35u) : CPK(f0[0] + f1[2], 2u);
      c[3] = lh2 ? CPK(f0[2] + f1[4], 36u) : CPK(f0[0] + f1[3], 3u);
      c[4] = lh2 ? CPK(f0[3] + f1[0], 48u) : CPK(f0[0] + f1[4], 4u);
      c[5] = lh2 ? CPK(f0[3] + f1[1], 49u) : CPK(f0[0] + f1[5], 5u);
      c[6] = lh2 ? CPK(f0[3] + f1[2], 50u) : CPK(f0[0] + f1[6], 6u);
      c[7] = lh2 ? CPK(f0[3] + f1[3], 51u) : CPK(f0[0] + f1[7], 7u);
      c[8] = lh2 ? CPK(f0[4] + f1[0], 64u) : CPK(f0[0] + f1[8], 8u);
      c[9] = lh2 ? CPK(f0[4] + f1[1], 65u) : CPK(f0[0] + f1[9], 9u);
      c[10] = lh2 ? CPK(f0[4] + f1[2], 66u) : CPK(f0[0] + f1[10], 10u);
      c[11] = lh2 ? CPK(f0[5] + f1[0], 80u) : CPK(f0[0] + f1[11], 11u);
      c[12] = lh2 ? CPK(f0[5] + f1[1], 81u) : CPK(f0[0] + f1[12], 12u);
      c[13] = lh2 ? CPK(f0[6] + f1[0], 96u) : CPK(f0[0] + f1[13], 13u);
      c[14] = lh2 ? CPK(f0[6] + f1[1], 97u) : CPK(f0[0] + f1[14], 14u);
      c[15] = lh2 ? CPK(f0[7] + f1[0], 112u) : CPK(f0[0] + f1[15], 15u);
      c[16] = lh2 ? CPK(f0[7] + f1[1], 113u) : CPK(f0[1] + f1[0], 16u);
      c[17] = lh2 ? CPK(f0[8] + f1[0], 128u) : CPK(f0[1] + f1[1], 17u);
      c[18] = lh2 ? CPK(f0[9] + f1[0], 144u) : CPK(f0[1] + f1[2], 18u);
      c[19] = lh2 ? CPK(f0[10] + f1[0], 160u) : CPK(f0[1] + f1[3], 19u);
      c[20] = lh2 ? CPK(f0[11] + f1[0], 176u) : CPK(f0[1] + f1[4], 20u);
      c[21] = lh2 ? CPK(f0[12] + f1[0], 192u) : CPK(f0[1] + f1[5], 21u);
      c[22] = lh2 ? CPK(f0[13] + f1[0], 208u) : CPK(f0[1] + f1[6], 22u);
      c[23] = lh2 ? CPK(f0[14] + f1[0], 224u) : CPK(f0[1] + f1[7], 23u);
      c[24] = lh2 ? CPK(f0[15] + f1[0], 240u) : CPK(f0[2] + f1[0], 32u);
      c[25] = 0xff800000u;
      c[26] = 0xff800000u;
      c[27] = 0xff800000u;
      c[28] = 0xff800000u;
      c[29] = 0xff800000u;
      c[30] = 0xff800000u;
      c[31] = 0xff800000u;
#undef CPK
      __builtin_amdgcn_sched_barrier(0);
      uint32_t ca[16], cb[16];
#pragma unroll
      for (int e = 0; e < 16; e++) { ca[e] = c[e]; cb[e] = c[16 + e]; }
      sort16_desc(ca); sort16_desc(cb); merge16_desc(ca, cb);
#pragma unroll
      for (int e = 0; e < 16; e++) cb[e] = (uint32_t)__shfl_xor((int)ca[e], 32);
      merge16_desc(ca, cb);
      __builtin_amdgcn_sched_barrier(0);
      const float vfirst = sort2f(ca[0] & ~255u);
      float ev[16]; float esum = 0.f;
#pragma unroll
      for (int e = 0; e < 16; e++) { ev[e] = __expf(sort2f(ca[e] & ~255u) - vfirst); esum += ev[e]; }
      const float einv = 1.f / esum;
      int eo[8]; float go[8];
      const uint32_t hmask = lh2 ? 0xffffffffu : 0u;
#pragma unroll
      for (int e = 0; e < 8; e++) {
        const uint32_t key = ca[e] ^ ((ca[e] ^ ca[8 + e]) & hmask);
        const int cc = (int)(key & 255u); const int i = cc >> 4, j = cc & 15;
        eo[e] = (int)(svl[tk * 32 + i] & 127u) * 128 + (int)(svl[tk * 32 + 16 + j] & 127u);
        go[e] = __uint_as_float(__float_as_uint(ev[e]) ^ ((__float_as_uint(ev[e]) ^ __float_as_uint(ev[8 + e])) & hmask)) * einv;
      }
      int* ip = seli + (size_t)rr * 128 + hd * 16 + 8 * lh2; float* gp = selg + (size_t)rr * 128 + hd * 16 + 8 * lh2;
      *(int4*)ip = make_int4(eo[0], eo[1], eo[2], eo[3]); *(int4*)(ip + 4) = make_int4(eo[4], eo[5], eo[6], eo[7]);
      *(float4*)gp = make_float4(go[0], go[1], go[2], go[3]); *(float4*)(gp + 4) = make_float4(go[4], go[5], go[6], go[7]);
    }
  }
}

DEVI float gelu_exact(float x) { return 0.5f * x * (1.f + erff(x * 0.70710678118654752f)); }

typedef float f32x2 __attribute__((ext_vector_type(2)));
DEVI float4 ldbf4(const uint16_t* p) { const uint2 v = *(const uint2*)p; return make_float4(bflo(v.x), bfhi(v.x), bflo(v.y), bfhi(v.y)); }
__device__ void phase_gather(const P& p, int vb, int nvb, char* smem) {
  const int t = tid_opaque(), wave = t >> 6, lane = t & 63, g = lane >> 4, j = lane & 15;
  const uint16_t* h2 = (const uint16_t*)(p.ws + WS_HB);
  const int* seli = (const int*)(p.ws + WS_SELI); const float* selg = (const float*)(p.ws + WS_SELG);
  const uint8_t* U = (const uint8_t*)(p.ws + WS_U8); const uint8_t* V = (const uint8_t*)(p.ws + WS_V8);
  const float* gf = p.in[15]; const float* gfin = p.in[20];
  uint32_t* kl = (uint32_t*)smem + wave * 1024;
  float* wl = (float*)(kl + 512);
  for (int base = (vb * 4 + wave) * 4; base < NREAL; base += nvb * 16) {
    const int rr = base + g;
    const uint16_t* hr = h2 + (size_t)rr * DM;
    f32x2 xf[32];
    {
      float ss = 0.f;
#pragma unroll
      for (int i = 0; i < 4; i++)
#pragma unroll
        for (int q = 0; q < 4; q++) {
          const float4 a = ldbf4(hr + i * 256 + 16 * j + 4 * q);
          ss += a.x * a.x + a.y * a.y + a.z * a.z + a.w * a.w;
        }
      const float rstd = rsqrtf(wsum16(ss) * (1.f / 1024.f) + EPS);
#pragma unroll
      for (int i = 0; i < 4; i++) {
#pragma unroll
        for (int q = 0; q < 4; q++) {
          const float4 a = ldbf4(hr + i * 256 + 16 * j + 4 * q);
          const float4 ga = *(const float4*)(gf + i * 256 + 16 * j + 4 * q);
          xf[i * 8 + q * 2 + 0] = f32x2{bf1((uint16_t)f2bf(a.x * rstd * ga.x)), bf1((uint16_t)f2bf(a.y * rstd * ga.y))};
          xf[i * 8 + q * 2 + 1] = f32x2{bf1((uint16_t)f2bf(a.z * rstd * ga.z)), bf1((uint16_t)f2bf(a.w * rstd * ga.w))};
        }
        __builtin_amdgcn_sched_barrier(0);
      }
    }
    {
      uint32_t ks[8];
      {
        const int4 a0 = *(const int4*)(seli + (size_t)rr * 128 + j * 8), a1 = *(const int4*)(seli + (size_t)rr * 128 + j * 8 + 4);
        const int ev[8] = {a0.x, a0.y, a0.z, a0.w, a1.x, a1.y, a1.z, a1.w};
#pragma unroll
        for (int r = 0; r < 8; r++) ks[r] = ((uint32_t)ev[r] << 7) | (uint32_t)(j * 8 + r);
      }
#pragma unroll
      for (int k = 2; k <= 128; k <<= 1) {
#pragma unroll
        for (int d = k >> 1; d > 0; d >>= 1) {
          if (d >= 8) {
#pragma unroll
            for (int r = 0; r < 8; r++) {
              const uint32_t o = (uint32_t)__shfl_xor((int)ks[r], d >> 3);
              const bool up = (((j * 8 + r) & k) == 0), lower = (((j * 8) & d) == 0);
              const uint32_t mn = ks[r] < o ? ks[r] : o, mx = ks[r] < o ? o : ks[r];
              ks[r] = (lower == up) ? mn : mx;
            }
          } else {
#pragma unroll
            for (int r = 0; r < 8; r++) {
              if ((r & d) == 0) {
                const bool up = (((j * 8 + r) & k) == 0);
                const uint32_t x0 = ks[r], x1 = ks[r | d];
                const uint32_t mn = x0 < x1 ? x0 : x1, mx = x0 < x1 ? x1 : x0;
                ks[r] = up ? mn : mx; ks[r | d] = up ? mx : mn;
              }
            }
          }
        }
      }
      *(uint4*)(kl + g * 128 + j * 8) = make_uint4(ks[0], ks[1], ks[2], ks[3]);
      *(uint4*)(kl + g * 128 + j * 8 + 4) = make_uint4(ks[4], ks[5], ks[6], ks[7]);
    }
    asm volatile("s_waitcnt lgkmcnt(0)" ::: "memory");
    const float* sgp = selg + (size_t)rr * 128;
    const uint32_t* mykl = kl + g * 128;
    float* mywl = wl + g * 128;
#pragma unroll 1
    for (int b0 = 0; b0 < 128; b0 += 8) {
      float dp[8];
#pragma unroll
      for (int u = 0; u < 8; u++) {
        const uint32_t key = mykl[b0 + u];
        const int e = (int)(key >> 7);
        const uint4* up = (const uint4*)(U + (size_t)e * 1024 + 16 * j);
        uint4 uu[4];
#pragma unroll
        for (int i = 0; i < 4; i++) uu[i] = up[i * 16];
        f32x2 d2 = f32x2{0.f, 0.f};
#pragma unroll
        for (int i = 0; i < 4; i++) {
          const uint32_t w[4] = {uu[i].x, uu[i].y, uu[i].z, uu[i].w};
#pragma unroll
          for (int q = 0; q < 4; q++) {
            d2 += __builtin_amdgcn_cvt_pk_f32_fp8((int)w[q], false) * xf[i * 8 + q * 2 + 0];
            d2 += __builtin_amdgcn_cvt_pk_f32_fp8((int)w[q], true) * xf[i * 8 + q * 2 + 1];
          }
        }
        dp[u] = d2.x + d2.y;
      }
      const bool h8 = (j & 8) != 0, h4 = (j & 4) != 0, h2b = (j & 2) != 0;
      float q4[4], q2[2];
#pragma unroll
      for (int k = 0; k < 4; k++) { const float snd = h8 ? dp[k] : dp[k + 4], kp = h8 ? dp[k + 4] : dp[k]; q4[k] = kp + __shfl_xor(snd, 8); }
#pragma unroll
      for (int k = 0; k < 2; k++) { const float snd = h4 ? q4[k] : q4[k + 2], kp = h4 ? q4[k + 2] : q4[k]; q2[k] = kp + __shfl_xor(snd, 4); }
      const float snd1 = h2b ? q2[0] : q2[1], kp1 = h2b ? q2[1] : q2[0];
      float q1 = kp1 + __shfl_xor(snd1, 2);
      q1 += __shfl_xor(q1, 1);
      if ((j & 1) == 0) mywl[b0 + (j >> 1)] = q1;
    }
    asm volatile("s_waitcnt lgkmcnt(0)" ::: "memory");
#pragma unroll
    for (int m = 0; m < 8; m++) {
      const int bb = j + 16 * m;
      const uint32_t key = mykl[bb];
      const float d = mywl[bb] * (1.f / USCALE);
      mywl[bb] = sgp[key & 127u] * gelu_exact(d) * (1.f / VSCALE);
    }
    asm volatile("s_waitcnt lgkmcnt(0)" ::: "memory");
    f32x2 acc[32];
#pragma unroll
    for (int i = 0; i < 32; i++) acc[i] = f32x2{0.f, 0.f};
#pragma unroll 8
    for (int bb = 0; bb < 128; bb++) {
      const uint32_t key = mykl[bb];
      const int e = (int)(key >> 7);
      const float wgt = mywl[bb];
      const uint4* vp = (const uint4*)(V + (size_t)e * 1024 + 16 * j);
      uint4 vv[4];
#pragma unroll
      for (int i = 0; i < 4; i++) vv[i] = vp[i * 16];
      const f32x2 w2 = f32x2{wgt, wgt};
#pragma unroll
      for (int i = 0; i < 4; i++) {
        const uint32_t w[4] = {vv[i].x, vv[i].y, vv[i].z, vv[i].w};
#pragma unroll
        for (int q = 0; q < 4; q++) {
          acc[i * 8 + q * 2 + 0] += w2 * __builtin_amdgcn_cvt_pk_f32_fp8((int)w[q], false);
          acc[i * 8 + q * 2 + 1] += w2 * __builtin_amdgcn_cvt_pk_f32_fp8((int)w[q], true);
        }
      }
    }
    asm volatile("" ::: "memory");
    float ss = 0.f;
#pragma unroll
    for (int i = 0; i < 4; i++) {
#pragma unroll
      for (int q = 0; q < 4; q++) {
        const float4 a = ldbf4(hr + i * 256 + 16 * j + 4 * q);
        const float v0 = acc[i * 8 + q * 2].x + a.x, v1 = acc[i * 8 + q * 2].y + a.y, v2 = acc[i * 8 + q * 2 + 1].x + a.z, v3 = acc[i * 8 + q * 2 + 1].y + a.w;
        acc[i * 8 + q * 2] = f32x2{v0, v1}; acc[i * 8 + q * 2 + 1] = f32x2{v2, v3};
        ss += v0 * v0 + v1 * v1 + v2 * v2 + v3 * v3;
      }
      __builtin_amdgcn_sched_barrier(0);
    }
    const float rstd = rsqrtf(wsum16(ss) * (1.f / 1024.f) + EPS);
    float* orow = p.out + (size_t)rr * DM;
#pragma unroll
    for (int i = 0; i < 4; i++) {
#pragma unroll
      for (int q = 0; q < 4; q++) {
        const float4 ga = *(const float4*)(gfin + i * 256 + 16 * j + 4 * q);
        *(float4*)(orow + i * 256 + 16 * j + 4 * q) =
            make_float4(acc[i * 8 + q * 2].x * rstd * ga.x, acc[i * 8 + q * 2].y * rstd * ga.y, acc[i * 8 + q * 2 + 1].x * rstd * ga.z, acc[i * 8 + q * 2 + 1].y * rstd * ga.w);
      }
      __builtin_amdgcn_sched_barrier(0);
    }
  }
}

#define XB_TMO      128
#define XB_XCNT(j)  (256  + 64 * (j))
#define XB_XSUB(j)  (1280 + 64 * (j))
#define XB_XGEN(j)  (2304 + 64 * (j))
#define XB_TOP      3328
#define XB_TOPGEN   3392
#define XCD_BAR_WORDS 3456
#define XB_SPIN_CAP (1u << 18)
#define LAS __attribute__((address_space(3)))

__device__ __forceinline__ unsigned xb_ld(unsigned* p)              { return __hip_atomic_load(p, __ATOMIC_RELAXED, __HIP_MEMORY_SCOPE_AGENT); }
__device__ __forceinline__ unsigned xb_add(unsigned* p, unsigned v) { return __hip_atomic_fetch_add(p, v, __ATOMIC_RELAXED, __HIP_MEMORY_SCOPE_AGENT); }
__device__ __forceinline__ unsigned xb_xcc_id() { return (unsigned)__builtin_amdgcn_s_getreg((3 << 11) | 20) & 0xFu; }
#define XB_SPIN(cond, bar) do { unsigned _sp = 0; while (cond) { __builtin_amdgcn_s_sleep(1); \
    if ((++_sp & 255u) == 0u) { if (xb_ld(&(bar)[XB_TMO])) break; if (_sp > XB_SPIN_CAP) { atomicAdd(&(bar)[XB_TMO], 1u); break; } } } } while (0)

struct XcdBarrier {
    unsigned* bar; unsigned x;
    volatile LAS unsigned* st;
};

__device__ __forceinline__ XcdBarrier xcd_barrier_post(unsigned* bar, volatile LAS unsigned* st) {
    XcdBarrier b; b.bar = bar; b.x = xb_xcc_id(); b.st = st;
    if (threadIdx.x == 0) (void)xb_add(&bar[XB_XCNT(b.x)], 1u);
    return b;
}
__device__ __forceinline__ void xcd_barrier_complete(unsigned* bar, unsigned x, unsigned& nloc, unsigned& nx) {
    const unsigned G = gridDim.x * gridDim.y * gridDim.z;
    unsigned sum, cnt, mine, sp = 0u;
    for (;;) {
        sum = 0u; cnt = 0u; mine = 0u;
#pragma unroll
        for (unsigned j = 0; j < 16; ++j) { const unsigned c = xb_ld(&bar[XB_XCNT(j)]); sum += c; cnt += (c > 0u) ? 1u : 0u; mine = (j == x) ? c : mine; }
        if (sum == G) break;
        __builtin_amdgcn_s_sleep(1);
        if ((++sp & 255u) == 0u) { if (xb_ld(&bar[XB_TMO])) break; if (sp > XB_SPIN_CAP) { atomicAdd(&bar[XB_TMO], 1u); break; } }
    }
    nloc = mine > 0u ? mine : 1u; nx = cnt > 0u ? cnt : 1u;
}

__device__ __forceinline__ void xcd_barrier(const XcdBarrier& b) {
    asm volatile("s_waitcnt vmcnt(0)" ::: "memory");
    __syncthreads();
    if (threadIdx.x == 0) {
        unsigned* bar = b.bar;
        __builtin_amdgcn_s_waitcnt(0);
        unsigned nloc = b.st[0], nx = b.st[1];
        if (nloc == 0u) { xcd_barrier_complete(bar, b.x, nloc, nx); b.st[0] = nloc; b.st[1] = nx; }
        const unsigned old = xb_add(&bar[XB_XSUB(b.x)], 1u);
        const unsigned gen = old / nloc;
        if (old + 1u == (gen + 1u) * nloc) {
            __builtin_amdgcn_fence(__ATOMIC_RELEASE, "agent");
            asm volatile("s_waitcnt vmcnt(0)" ::: "memory");
            const unsigned og = xb_add(&bar[XB_TOP], 1u);
            const unsigned tg = og / nx;
            if (og + 1u == (tg + 1u) * nx) xb_add(&bar[XB_TOPGEN], 1u);
            else XB_SPIN(xb_ld(&bar[XB_TOPGEN]) == tg, bar);
            __builtin_amdgcn_fence(__ATOMIC_ACQUIRE, "agent");
            xb_add(&bar[XB_XGEN(b.x)], 1u);
            asm volatile("s_waitcnt vmcnt(0)" ::: "memory");
        } else {
            XB_SPIN(xb_ld(&bar[XB_XGEN(b.x)]) == gen, bar);
            __builtin_amdgcn_fence(__ATOMIC_ACQUIRE, "agent");
            asm volatile("s_waitcnt vmcnt(0)" ::: "memory");
        }
    }
    __syncthreads();
}

constexpr int NPHASE = 8;
template <int PH> DEVI void run_phase(const P& p, int vb, int nvb, char* smem, int var = 0) {
  if (PH == 0) phase_prep(p, vb, nvb);
  if (PH == 1) phase_gemm_z(p, vb, nvb, smem);
  if (PH == 2) phase_conv(p, vb, nvb, smem);
  if (PH == 3) phase_gemm_qkv(p, vb, nvb, smem);
  if (PH == 4) phase_attn(p, vb, nvb, smem);
  if (PH == 5) phase_gemm_out(p, vb, nvb, smem, var);
  if (PH == 6) phase_peer_q(p, vb, nvb, smem);
  if (PH == 7) phase_gather(p, vb, nvb, smem);
}
template <int PH> __global__ void __launch_bounds__(256, 2) k_phase(P p) {
  extern __shared__ __attribute__((aligned(16))) char smem[];
  run_phase<PH>(p, blockIdx.x, gridDim.x, smem);
}
#if MEGA
#ifndef PROBE_DUP
#define PROBE_DUP -1
#endif
#ifndef PROBE_VAR
#define PROBE_VAR 0
#endif
#define RUN_PH(N, SYNC)                                                    \
  _Pragma("unroll 1") for (int rep_ = 0; rep_ < (PROBE_DUP == N ? 2 : 1); rep_++) { \
    run_phase<N>(p, vb, nvb, smem, rep_ == 0 ? 0 : PROBE_VAR);             \
    if (SYNC || rep_ + 1 < (PROBE_DUP == N ? 2 : 1)) { if (N == 0) grid.sync(); else xcd_barrier(xb); } \
  }
__global__ void __launch_bounds__(256, 2) k_main(P p) {
  extern __shared__ __attribute__((aligned(16))) char smem[];
  const int vb = blockIdx.x, nvb = gridDim.x;
  cg::grid_group grid = cg::this_grid();
  __shared__ uint4 xb_words;
  if (threadIdx.x == 0) xb_words = make_uint4(0u, 0u, 0u, 0u);
  __syncthreads();
  const XcdBarrier xb = xcd_barrier_post((unsigned*)(p.ws + WS_BAR), (volatile LAS unsigned*)&xb_words);
  RUN_PH(0, true)
  RUN_PH(1, true)
  RUN_PH(2, (PROBE_DUP == 2))
  RUN_PH(3, true)
  RUN_PH(4, true)
  RUN_PH(5, true)
  RUN_PH(6, true)
  RUN_PH(7, false)
}
#endif

template <int PH> static void launch_phase(const P& p, int nblk, hipStream_t stream) {
  static bool attr = false;
  if (!attr) { (void)hipFuncSetAttribute((const void*)k_phase<PH>, hipFuncAttributeMaxDynamicSharedMemorySize, LDS_BYTES); attr = true; }
  hipLaunchKernelGGL(k_phase<PH>, dim3(nblk), dim3(256), LDS_BYTES, stream, p);
}

extern "C" void kernel_launch(void* const* d_in, const int* in_sizes, int n_in, void* d_out, int out_size, void* d_ws, size_t ws_size, hipStream_t stream) {
  static int grid = 0;
  if (grid == 0) {
    if (n_in != 21 || ws_size < WS_TOTAL) { fprintf(stderr, "kernel_launch: unexpected n_in %d / ws %zu (need %zu)\n", n_in, ws_size, (size_t)WS_TOTAL); grid = -1; return; }
#if MEGA
    int dev = 0, cus = 0, per_cu = 0;
    (void)hipGetDevice(&dev);
    (void)hipDeviceGetAttribute(&cus, hipDeviceAttributeMultiprocessorCount, dev);
    (void)hipFuncSetAttribute((const void*)k_main, hipFuncAttributeMaxDynamicSharedMemorySize, LDS_BYTES);
    (void)hipOccupancyMaxActiveBlocksPerMultiprocessor(&per_cu, (const void*)k_main, 256, LDS_BYTES);
    if (per_cu < 1) per_cu = 1;
    if (per_cu > 2) per_cu = 2;
    grid = cus * per_cu;
    fprintf(stderr, "kernel_launch: cus %d per_cu %d grid %d\n", cus, per_cu, grid);
#else
    grid = 512;
#endif
  }
  if (grid < 0) return;
  P p{};
  for (int i = 0; i < 21; i++) p.in[i] = (const float*)d_in[i];
  p.out = (float*)d_out; p.ws = (char*)d_ws;
#if MEGA
  (void)hipMemsetAsync((char*)d_ws + WS_BAR, 0, WS_BAR_BYTES, stream);
  void* args[] = {&p};
  hipError_t e = hipLaunchCooperativeKernel((const void*)k_main, dim3(grid), dim3(256), args, LDS_BYTES, stream);
  if (e != hipSuccess) fprintf(stderr, "cooperative launch failed: %s (grid %d)\n", hipGetErrorString(e), grid);
#else
  launch_phase<0>(p, 2048, stream);
  launch_phase<1>(p, 264 * 12, stream);
  launch_phase<2>(p, 2112, stream);
  launch_phase<3>(p, 264 * 14, stream);
  launch_phase<4>(p, 64 * 17, stream);
  launch_phase<5>(p, 2048, stream);
  launch_phase<6>(p, 2048, stream);
  launch_phase<7>(p, 8192, stream);
#endif
}
```

```cpp
#include <hip/hip_runtime.h>
#include <hip/hip_cooperative_groups.h>
#include <stdint.h>
#include <cstdio>
namespace cg = cooperative_groups;

#ifndef MEGA
#define MEGA 1
#endif
#ifndef NAIVE_GEMM
#define NAIVE_GEMM 0
#endif
#ifndef NAIVE_ATTN
#define NAIVE_ATTN 0
#endif

#define DEVI __device__ __forceinline__

constexpr int DM = 1024;
constexpr int NBATCH = 8;
constexpr int SEQ = 4096;
constexpr int NMETA = 16;
constexpr int TP = 4224;
constexpr int NTOK = NBATCH * TP;
constexpr int NREAL = NBATCH * SEQ;
constexpr int ZW = 1408;
constexpr float EPS = 1e-6f;
constexpr float QSCALE = 0.14724574f;
constexpr float USCALE = 256.f, VSCALE = 64.f;

constexpr size_t al256(size_t x) { return (x + 255) & ~(size_t)255; }
constexpr size_t WS_WT_IN = 0;
constexpr size_t WS_WT_UQ = WS_WT_IN + al256((size_t)1536 * 1024 * 2);
constexpr size_t WS_WT_UK = WS_WT_UQ + al256((size_t)768 * 256 * 2);
constexpr size_t WS_WT_UV = WS_WT_UK + al256((size_t)512 * 128 * 2);
constexpr size_t WS_WT_OUT = WS_WT_UV + al256((size_t)512 * 128 * 2);
constexpr size_t WS_WT_PQ = WS_WT_OUT + al256((size_t)1024 * 1024 * 2);
constexpr size_t WS_KEYS = WS_WT_PQ + al256((size_t)1024 * 1024 * 2);
constexpr size_t WS_ROPE = WS_KEYS + al256((size_t)8 * 2 * 128 * 64 * 2);
constexpr size_t WS_U8 = WS_ROPE + al256((size_t)TP * 16 * 2 * 4);
constexpr size_t WS_V8 = WS_U8 + al256((size_t)16384 * 1024);
constexpr size_t WS_MIXED = WS_V8 + al256((size_t)16384 * 1024);
constexpr size_t WS_HB = WS_MIXED + al256((size_t)NTOK * 1024 * 2);
constexpr size_t WS_R1 = WS_HB + al256((size_t)NTOK * 1024 * 2);
constexpr size_t WS_Z = WS_R1;
constexpr size_t WS_KROPE = WS_Z + al256((size_t)NTOK * ZW * 2);
constexpr size_t WS_Q = WS_KROPE + al256((size_t)NTOK * 32 * 2);
constexpr size_t WS_KN = WS_Q + al256((size_t)NTOK * 768 * 2);
constexpr size_t WS_VT = WS_KN + al256((size_t)NTOK * 512 * 2);
constexpr size_t WS_R1_END = WS_VT + al256((size_t)NTOK * 512 * 2);
constexpr size_t WS_H2 = WS_R1;
constexpr size_t WS_SELI = WS_H2 + al256((size_t)NREAL * 1024 * 4);
constexpr size_t WS_SELG = WS_SELI + al256((size_t)NREAL * 128 * 4);
constexpr size_t WS_SEL_END = WS_SELG + al256((size_t)NREAL * 128 * 4);
static_assert(WS_SEL_END <= WS_R1_END, "overlay does not fit");
constexpr size_t WS_BAR = WS_R1_END;
constexpr size_t WS_BAR_BYTES = 16384;
constexpr size_t WS_TOTAL = WS_BAR + WS_BAR_BYTES;

constexpr int LDS_AS = 0;
constexpr int LDS_BS = 36864;
constexpr int LDS_RS = 73728;
constexpr int LDS_SCR = 73728 + 512;
constexpr int LDS_BYTES = LDS_SCR + 1024;
constexpr int CT_LD = 132;

struct P {
  const float* in[21];
  float* out;
  char* ws;
};

DEVI uint32_t f2bf(float f) { uint32_t u = __float_as_uint(f); return (u + 0x7fffu + ((u >> 16) & 1u)) >> 16; }
DEVI float bflo(uint32_t w) { return __uint_as_float(w << 16); }
DEVI float bfhi(uint32_t w) { return __uint_as_float(w & 0xffff0000u); }
DEVI float bf1(uint16_t h) { return __uint_as_float(((uint32_t)h) << 16); }
typedef __bf16 hwbf16x2 __attribute__((ext_vector_type(2)));
typedef float hwf32x2 __attribute__((ext_vector_type(2)));
DEVI uint32_t pk(float a, float b) { const hwf32x2 v = {a, b}; return __builtin_bit_cast(uint32_t, __builtin_convertvector(v, hwbf16x2)); }
DEVI float wsum16(float v) {
  v += __shfl_xor(v, 1); v += __shfl_xor(v, 2); v += __shfl_xor(v, 4); v += __shfl_xor(v, 8); return v;
}
DEVI float wsum64(float v) { v = wsum16(v); v += __shfl_xor(v, 16); v += __shfl_xor(v, 32); return v; }
DEVI uint32_t wmaxu(uint32_t v) {
#pragma unroll
  for (int o = 1; o < 64; o <<= 1) { uint32_t t = (uint32_t)__shfl_xor((int)v, o); v = v > t ? v : t; }
  return v;
}
DEVI uint32_t f2sort(float f) { return __float_as_uint(f); }
DEVI float sort2f(uint32_t s) { return __uint_as_float(s); }

typedef __attribute__((ext_vector_type(2))) __bf16 bf16x2_t;
DEVI float dot2bf(uint32_t a, uint32_t b, float acc) { return __builtin_amdgcn_fdot2_f32_bf16(__builtin_bit_cast(bf16x2_t, a), __builtin_bit_cast(bf16x2_t, b), acc, false); }
DEVI int tid_opaque() { int t = threadIdx.x; asm volatile("" : "+v"(t)); return t; }
typedef __attribute__((ext_vector_type(8))) short bf16x8;
typedef __attribute__((ext_vector_type(16))) float f32x16;

union Frag { bf16x8 v; uint32_t u[4]; uint2 d[2]; uint4 q; };
#define CE_DESC(x, y) { const float a_ = __uint_as_float(x), b_ = __uint_as_float(y); (x) = __float_as_uint(__builtin_fmaxf(a_, b_)); (y) = __float_as_uint(__builtin_fminf(a_, b_)); }
DEVI void sort16_desc(uint32_t (&a)[16]) {
#pragma unroll
  for (int k = 2; k <= 16; k <<= 1) {
#pragma unroll
    for (int j = k >> 1; j > 0; j >>= 1) {
#pragma unroll
      for (int i = 0; i < 16; i++) {
        const int l = i ^ j;
        if (l > i) { if ((i & k) == 0) CE_DESC(a[i], a[l]) else CE_DESC(a[l], a[i]) }
      }
    }
  }
}
DEVI void merge16_desc(uint32_t (&x)[16], const uint32_t (&y)[16]) {
#pragma unroll
  for (int i = 0; i < 16; i++) x[i] = __float_as_uint(__builtin_fmaxf(__uint_as_float(x[i]), __uint_as_float(y[15 - i])));
#pragma unroll
  for (int j = 8; j > 0; j >>= 1) {
#pragma unroll
    for (int i = 0; i < 16; i++) {
      const int l = i ^ j;
      if (l > i) CE_DESC(x[i], x[l])
    }
  }
}

DEVI const float* hrow_ptr(const P& p, int prow, bool& zero) {
  const int b = prow / TP, tt = prow - b * TP;
  zero = false;
  if (tt < NMETA) return p.in[1] + (size_t)tt * DM;
  if (tt < NMETA + SEQ) return p.in[0] + ((size_t)b * SEQ + (tt - NMETA)) * DM;
  zero = true; return p.in[0];
}

__device__ void phase_prep(const P& p, int vb, int nvb) {
  const size_t gid = (size_t)vb * 256 + tid_opaque(), gsz = (size_t)nvb * 256;
  char* ws = p.ws;
  {
    uint16_t* o = (uint16_t*)(ws + WS_WT_IN); const float* w = p.in[3]; const float* g = p.in[2];
    for (size_t i = gid; i < (size_t)512 * 1440; i += gsz) {
      const int k = 2 * (int)(i / 1440), n = (int)(i % 1440);
      *(uint32_t*)(o + (size_t)n * 1024 + k) = pk(w[(size_t)k * 1440 + n] * g[k], w[(size_t)(k + 1) * 1440 + n] * g[k + 1]);
    }
    for (size_t i = gid; i < (size_t)96 * 512; i += gsz) *(uint32_t*)(o + (size_t)1440 * 1024 + i * 2) = 0u;
  }
  {
    uint16_t* o = (uint16_t*)(ws + WS_WT_UQ); const float* w = p.in[5]; const float* g = p.in[4];
    for (size_t i = gid; i < (size_t)128 * 768; i += gsz) {
      const int k = 2 * (int)(i / 768), n = (int)(i % 768);
      *(uint32_t*)(o + (size_t)n * 256 + k) = pk(w[(size_t)k * 768 + n] * g[k] * QSCALE, w[(size_t)(k + 1) * 768 + n] * g[k + 1] * QSCALE);
    }
  }
  {
    uint16_t* ok = (uint16_t*)(ws + WS_WT_UK); uint16_t* ov = (uint16_t*)(ws + WS_WT_UV); const float* w = p.in[7]; const float* g = p.in[6];
    for (size_t i = gid; i < (size_t)64 * 1024; i += gsz) {
      const int k = 2 * (int)(i >> 10), c = (int)(i & 1023); const int h = c >> 7, d = c & 127;
      const uint32_t v = pk(w[(size_t)k * 1024 + c] * g[k], w[(size_t)(k + 1) * 1024 + c] * g[k + 1]);
      if (d < 64) *(uint32_t*)(ok + (size_t)(h * 64 + d) * 128 + k) = v; else *(uint32_t*)(ov + (size_t)(h * 64 + d - 64) * 128 + k) = v;
    }
  }
  {
    uint16_t* o = (uint16_t*)(ws + WS_WT_OUT); const float* w = p.in[14]; const float* ga = p.in[12]; const float* gc = p.in[13];
    for (size_t i = gid; i < (size_t)512 * 1024; i += gsz) {
      const int k = 2 * (int)(i >> 10), n = (int)(i & 1023);
      const float g0 = k < 512 ? ga[k] : gc[k - 512], g1 = k < 512 ? ga[k + 1] : gc[k + 1 - 512];
      *(uint32_t*)(o + (size_t)n * 1024 + k) = pk(w[(size_t)k * 1024 + n] * g0, w[(size_t)(k + 1) * 1024 + n] * g1);
    }
  }
  {
    uint16_t* o = (uint16_t*)(ws + WS_WT_PQ); const float* w = p.in[16]; const float* g = p.in[15];
    for (size_t i = gid; i < (size_t)512 * 1024; i += gsz) {
      const int k = 2 * (int)(i >> 10), n = (int)(i & 1023);
      *(uint32_t*)(o + (size_t)n * 1024 + k) = pk(w[(size_t)k * 1024 + n] * g[k], w[(size_t)(k + 1) * 1024 + n] * g[k + 1]);
    }
  }
  {
    uint16_t* o = (uint16_t*)(ws + WS_KEYS); const float* w = p.in[17];
    for (size_t i = gid; i < (size_t)8 * 2 * 128 * 64; i += gsz) o[i] = (uint16_t)f2bf(w[i]);
  }
  {
    float* ct = (float*)(ws + WS_ROPE); float* st = ct + TP * 16;
    for (size_t i = gid; i < (size_t)TP * 16; i += gsz) {
      int pos = (int)(i >> 4), j = (int)(i & 15);
      float fr = powf(10000.0f, -(float)j / 16.0f); float ang = (float)pos * fr;
      ct[i] = cosf(ang); st[i] = sinf(ang);
    }
  }
  {
    uint4* hb = (uint4*)(ws + WS_HB);
    for (size_t i = gid; i < (size_t)NTOK * 128; i += gsz) {
      const int prow = (int)(i >> 7), c = (int)(i & 127);
      bool zf; const float* src = hrow_ptr(p, prow, zf);
      uint4 o = make_uint4(0u, 0u, 0u, 0u);
      if (!zf) { const float4 a = *(const float4*)(src + c * 8), b = *(const float4*)(src + c * 8 + 4); o = make_uint4(pk(a.x, a.y), pk(a.z, a.w), pk(b.x, b.y), pk(b.z, b.w)); }
      hb[i] = o;
    }
  }
}

__device__ void convert_tables(const P& p, int vb, int nvb) {
  const size_t gid = (size_t)vb * 256 + tid_opaque(), gsz = (size_t)nvb * 256;
  char* ws = p.ws;
  {
    const float4* u = (const float4*)p.in[18]; const float4* v = (const float4*)p.in[19];
    uint4* ou = (uint4*)(ws + WS_U8); uint4* ov = (uint4*)(ws + WS_V8);
    for (size_t i = gid; i < (size_t)16384 * 1024 / 16; i += gsz) {
      uint32_t w[4];
#pragma unroll
      for (int q = 0; q < 4; q++) {
        const float4 a = u[i * 4 + q]; int x = 0;
        x = __builtin_amdgcn_cvt_pk_fp8_f32(a.x * USCALE, a.y * USCALE, x, false);
        x = __builtin_amdgcn_cvt_pk_fp8_f32(a.z * USCALE, a.w * USCALE, x, true);
        w[q] = (uint32_t)x;
      }
      ou[i] = make_uint4(w[0], w[1], w[2], w[3]);
#pragma unroll
      for (int q = 0; q < 4; q++) {
        const float4 a = v[i * 4 + q]; int x = 0;
        x = __builtin_amdgcn_cvt_pk_fp8_f32(a.x * VSCALE, a.y * VSCALE, x, false);
        x = __builtin_amdgcn_cvt_pk_fp8_f32(a.z * VSCALE, a.w * VSCALE, x, true);
        w[q] = (uint32_t)x;
      }
      ov[i] = make_uint4(w[0], w[1], w[2], w[3]);
    }
  }
}

template <int AMODE, bool TRANS, bool MID, int K>
DEVI void gemm_core(char* smem, const char* const (&arow)[4], const bool (&azero)[4], const uint16_t* __restrict__ Bt, int n0, int rot, int ktmask = 0xffff, int bm = 1) {
  uint16_t* As = (uint16_t*)(smem + LDS_AS);
  uint16_t* Bs = (uint16_t*)(smem + LDS_BS);
  float* rs = (float*)(smem + LDS_RS);
  float* Ct = (float*)smem;
  const int t = tid_opaque();
  const int kc = t & 7, r0 = t >> 3;
  constexpr int KT = K >> 6;
#if NAIVE_GEMM
  {
    const int ty = t >> 4, tx = t & 15;
    __syncthreads();
    const char** rp = (const char**)(smem + 40960); int* rz = (int*)(smem + 40960 + 1024);
    if (kc == 0) { for (int i = 0; i < 4; i++) { rp[r0 + 32 * i] = arow[i]; rz[r0 + 32 * i] = azero[i] ? 1 : 0; } }
    __syncthreads();
    float c[8][8];
    for (int i = 0; i < 8; i++) for (int j = 0; j < 8; j++) c[i][j] = 0.f;
    float sq[8] = {0, 0, 0, 0, 0, 0, 0, 0};
    const char* myrow[8]; int myz[8];
    for (int i = 0; i < 8; i++) { myrow[i] = rp[ty * 8 + i]; myz[i] = rz[ty * 8 + i]; }
    __syncthreads();
    for (int k = 0; k < K; k++) {
      if (MID && k == 512) {
        if (tx == 0) for (int i = 0; i < 8; i++) rs[ty * 8 + i] = rsqrtf(sq[i] / 512.f + EPS);
        __syncthreads();
        for (int i = 0; i < 8; i++) { float s = rs[ty * 8 + i]; for (int j = 0; j < 8; j++) c[i][j] *= s; }
      }
      float a[8], b[8];
      for (int i = 0; i < 8; i++) {
        float v;
        if (AMODE == 0) v = bf1(((const uint16_t*)myrow[i])[k]);
        else { v = myz[i] ? 0.f : ((const float*)myrow[i])[k]; }
        if (!MID || k < 512) sq[i] += v * v;
        a[i] = bf1((uint16_t)f2bf(v));
      }
      for (int j = 0; j < 8; j++) b[j] = bf1(Bt[(size_t)(n0 + tx * 8 + j) * K + k]);
      for (int i = 0; i < 8; i++) for (int j = 0; j < 8; j++) c[i][j] += a[i] * b[j];
    }
    __syncthreads();
    if (!MID && tx == 0) for (int i = 0; i < 8; i++) rs[ty * 8 + i] = rsqrtf(sq[i] / (float)K + EPS);
    for (int i = 0; i < 8; i++) for (int j = 0; j < 8; j++) {
      if (TRANS) Ct[(tx * 8 + j) * CT_LD + ty * 8 + i] = c[i][j]; else Ct[(ty * 8 + i) * CT_LD + tx * 8 + j] = c[i][j];
    }
    __syncthreads();
    return;
  }
#else
  const int wave = t >> 6, lane = t & 63, wm = wave >> 1, wn = wave & 1, lr = lane & 31, lh = lane >> 5;
  f32x16 acc[2][2];
#pragma unroll
  for (int i = 0; i < 2; i++)
#pragma unroll
    for (int j = 0; j < 2; j++)
#pragma unroll
      for (int r = 0; r < 16; r++) acc[i][j][r] = 0.f;
  uint4 xa00, xa01, xa02, xa03, xa10, xa11, xa12, xa13;
  uint4 xb00, xb01, xb02, xb03, xb10, xb11, xb12, xb13;
  float4 fa00, fa01, fa02, fa03, fa10, fa11, fa12, fa13;
  float4 fb00, fb01, fb02, fb03, fb10, fb11, fb12, fb13;
  float ssq0 = 0.f, ssq1 = 0.f, ssq2 = 0.f, ssq3 = 0.f;
  const float4 zero4 = make_float4(0.f, 0.f, 0.f, 0.f);
  const uint16_t* brow = Bt + (size_t)(n0 + r0 * bm) * K + kc * 8;
#define GL_LD1(i, S)                                                                                             \
  {                                                                                                              \
    if (AMODE == 0) {                                                                                            \
      xa##S##i = *(const uint4*)(arow[i] + ((size_t)kt_ * 64 + kc * 8) * 2);                                     \
    } else {                                                                                                     \
      fa##S##i = zero4; fb##S##i = zero4;                                                                        \
      if (!azero[i]) {                                                                                           \
        const float* src_ = (const float*)(arow[i]) + kt_ * 64 + kc * 8;                                         \
        fa##S##i = *(const float4*)src_; fb##S##i = *(const float4*)(src_ + 4);                                  \
      }                                                                                                          \
    }                                                                                                            \
    xb##S##i = *(const uint4*)(brow + (size_t)(32 * i * bm) * K + kt_ * 64);                                     \
  }
#define GL_LOAD(KT_, S) { int kt_ = MID ? (((KT_) & 8) | (((KT_) + rot) & 7)) : (((KT_) + rot) & (KT - 1)); kt_ &= ktmask; asm volatile("" : "+s"(kt_)); GL_LD1(0, S) GL_LD1(1, S) GL_LD1(2, S) GL_LD1(3, S) }
#define GL_ST1(i, S, BUF_, SSQ)                                                                                  \
  {                                                                                                              \
    uint4 ra_;                                                                                                   \
    if (AMODE == 0) {                                                                                            \
      ra_ = xa##S##i;                                                                                            \
      if (dossq_) {                                                                                              \
        SSQ = dot2bf(ra_.x, ra_.x, SSQ); SSQ = dot2bf(ra_.y, ra_.y, SSQ);                                        \
        SSQ = dot2bf(ra_.z, ra_.z, SSQ); SSQ = dot2bf(ra_.w, ra_.w, SSQ);                                        \
      }                                                                                                          \
    } else {                                                                                                     \
      const float4 f0 = fa##S##i, f1 = fb##S##i;                                                                 \
      if (dossq_) SSQ += f0.x * f0.x + f0.y * f0.y + f0.z * f0.z + f0.w * f0.w + f1.x * f1.x + f1.y * f1.y + f1.z * f1.z + f1.w * f1.w; \
      ra_ = make_uint4(pk(f0.x, f0.y), pk(f0.z, f0.w), pk(f1.x, f1.y), pk(f1.z, f1.w));                          \
    }                                                                                                            \
    *(uint4*)(As + (size_t)(BUF_) * 128 * 72 + (r0 + 32 * i) * 72 + kc * 8) = ra_;                               \
    *(uint4*)(Bs + (size_t)(BUF_) * 128 * 72 + (r0 + 32 * i) * 72 + kc * 8) = xb##S##i;                          \
  }
#define GL_STORE(BUF_, S, DOSSQ_) { const bool dossq_ = (DOSSQ_); GL_ST1(0, S, BUF_, ssq0) GL_ST1(1, S, BUF_, ssq1) GL_ST1(2, S, BUF_, ssq2) GL_ST1(3, S, BUF_, ssq3) }
#define GL_RS1(i, SSQ, DEN_)                                                                                     \
  {                                                                                                              \
    float s_ = SSQ;                                                                                              \
    s_ += __shfl_xor(s_, 1); s_ += __shfl_xor(s_, 2); s_ += __shfl_xor(s_, 4);                                   \
    if (kc == 0) rs[r0 + 32 * i] = rsqrtf(s_ / (DEN_) + EPS);                                                    \
  }
#define GL_RS(DEN_) { GL_RS1(0, ssq0, DEN_) GL_RS1(1, ssq1, DEN_) GL_RS1(2, ssq2, DEN_) GL_RS1(3, ssq3, DEN_) }
#define GL_COMPUTE(BUF_)                                                                                         \
  {                                                                                                              \
    const uint16_t* Ab = As + (size_t)(BUF_) * 128 * 72;                                                         \
    const uint16_t* Bb = Bs + (size_t)(BUF_) * 128 * 72;                                                         \
    _Pragma("unroll") for (int ks = 0; ks < 4; ks++) {                                                           \
      bf16x8 a[2], b[2];                                                                                         \
      _Pragma("unroll") for (int mi = 0; mi < 2; mi++) a[mi] = *(const bf16x8*)(Ab + (64 * wm + 32 * mi + lr) * 72 + 16 * ks + 8 * lh); \
      _Pragma("unroll") for (int ni = 0; ni < 2; ni++) b[ni] = *(const bf16x8*)(Bb + (64 * wn + 32 * ni + lr) * 72 + 16 * ks + 8 * lh); \
      _Pragma("unroll") for (int mi = 0; mi < 2; mi++)                                                           \
        _Pragma("unroll") for (int ni = 0; ni < 2; ni++) {                                                       \
          if (TRANS) acc[mi][ni] = __builtin_amdgcn_mfma_f32_32x32x16_bf16(b[ni], a[mi], acc[mi][ni], 0, 0, 0);  \
          else acc[mi][ni] = __builtin_amdgcn_mfma_f32_32x32x16_bf16(a[mi], b[ni], acc[mi][ni], 0, 0, 0);        \
        }                                                                                                        \
      if (ks == 1) __builtin_amdgcn_sched_barrier(0);                                                            \
    }                                                                                                            \
  }
  __syncthreads();
  GL_LOAD(0, 0);
  GL_LOAD(1, 1);
  GL_STORE(0, 0, true);
  __syncthreads();
  if (KT <= 4) {
    if (KT > 2) GL_LOAD(2, 0);
#pragma unroll
    for (int kt = 0; kt < KT; kt += 2) {
      GL_COMPUTE(0);
      GL_STORE(1, 1, true);
      if (kt + 3 < KT) GL_LOAD(kt + 3, 1);
      __syncthreads();
      GL_COMPUTE(1);
      if (kt + 2 < KT) {
        GL_STORE(0, 0, true);
        if (kt + 4 < KT) GL_LOAD(kt + 4, 0);
      }
      __syncthreads();
    }
  } else {
    GL_LOAD(2, 0);
#pragma unroll 1
    for (int kt = 0; kt < KT; kt += 2) {
      if (MID && kt == 8) {
        GL_RS(512.f);
        __syncthreads();
#pragma unroll
        for (int mi = 0; mi < 2; mi++) {
          f32x16 sv;
#pragma unroll
          for (int r = 0; r < 16; r++) sv[r] = rs[64 * wm + 32 * mi + (r & 3) + 8 * (r >> 2) + 4 * lh];
          acc[mi][0] *= sv; acc[mi][1] *= sv;
        }
      }
      GL_COMPUTE(0);
      GL_STORE(1, 1, !MID || (kt + 1) < 8);
      GL_LOAD((kt + 3 < KT ? kt + 3 : KT - 1), 1);
      __syncthreads();
      GL_COMPUTE(1);
      GL_STORE(0, 0, (kt + 2 < KT) && (!MID || (kt + 2) < 8));
      GL_LOAD((kt + 4 < KT ? kt + 4 : KT - 1), 0);
      __syncthreads();
    }
  }
  if (!MID) GL_RS((float)K);
#pragma unroll
  for (int mi = 0; mi < 2; mi++)
#pragma unroll
    for (int ni = 0; ni < 2; ni++)
#pragma unroll
      for (int r = 0; r < 16; r++) {
        const int ri = (r & 3) + 8 * (r >> 2) + 4 * lh;
        if (TRANS) Ct[(64 * wn + 32 * ni + ri) * CT_LD + 64 * wm + 32 * mi + lr] = acc[mi][ni][r];
        else Ct[(64 * wm + 32 * mi + ri) * CT_LD + 64 * wn + 32 * ni + lr] = acc[mi][ni][r];
      }
  __syncthreads();
#endif
}

__device__ void phase_gemm_z(const P& p, int vb, int nvb, char* smem) {
  const int t = tid_opaque(), kc = t & 7, r0 = t >> 3;
  const float* Ct = (const float*)smem; const float* rs = (const float*)(smem + LDS_RS);
  uint16_t* z = (uint16_t*)(p.ws + WS_Z); uint16_t* krope = (uint16_t*)(p.ws + WS_KROPE);
  const float* cost = (const float*)(p.ws + WS_ROPE); const float* sint = cost + TP * 16;
  const bool xs = (nvb & 7) == 0;
  const int xcd = vb & 7, slot = vb >> 3, nslot = nvb >> 3;
  for (int li = xs ? slot : vb; li < (xs ? 33 * 12 : 264 * 12); li += (xs ? nslot : nvb)) {
    const int mt = xs ? (li / 12) * 8 + xcd : li / 12, nt = li % 12;
    const char* arow[4]; const bool az[4] = {false, false, false, false};
#pragma unroll
    for (int i = 0; i < 4; i++) arow[i] = p.ws + WS_HB + (size_t)(mt * 128 + r0 + 32 * i) * 2048;
    gemm_core<0, false, false, 1024>(smem, arow, az, (const uint16_t*)(p.ws + WS_WT_IN), nt * 128, (nt * 4) / 3);
    const int c8 = t & 15;
    if (nt < 11) {
#pragma unroll
      for (int i = 0; i < 8; i++) {
        const int r = (t >> 4) + 16 * i; const float s = rs[r];
        const float4 v0 = *(const float4*)(Ct + r * CT_LD + c8 * 8), v1 = *(const float4*)(Ct + r * CT_LD + c8 * 8 + 4);
        uint4 o = make_uint4(pk(v0.x * s, v0.y * s), pk(v0.z * s, v0.w * s), pk(v1.x * s, v1.y * s), pk(v1.z * s, v1.w * s));
        *(uint4*)(z + (size_t)(mt * 128 + r) * ZW + nt * 128 + c8 * 8) = o;
      }
    } else if (c8 < 2) {
#pragma unroll
      for (int i = 0; i < 8; i++) {
        const int r = (t >> 4) + 16 * i; const float s = rs[r];
        const int prow = mt * 128 + r; const int pos = prow % TP;
        float o1[8], o2[8];
#pragma unroll
        for (int e = 0; e < 8; e++) {
          const int c = c8 * 8 + e;
          const float x1 = Ct[r * CT_LD + c] * s, x2 = Ct[r * CT_LD + c + 16] * s;
          const float cs = cost[pos * 16 + c], sn = sint[pos * 16 + c];
          o1[e] = x1 * cs - x2 * sn; o2[e] = x2 * cs + x1 * sn;
        }
        *(uint4*)(krope + (size_t)prow * 32 + c8 * 8) = make_uint4(pk(o1[0], o1[1]), pk(o1[2], o1[3]), pk(o1[4], o1[5]), pk(o1[6], o1[7]));
        *(uint4*)(krope + (size_t)prow * 32 + 16 + c8 * 8) = make_uint4(pk(o2[0], o2[1]), pk(o2[2], o2[3]), pk(o2[4], o2[5]), pk(o2[6], o2[7]));
      }
    }
  }
}

DEVI float fast_sigmoid(float x) { return __builtin_amdgcn_rcpf(1.f + __expf(-x)); }
__device__ void phase_conv(const P& p, int vb, int nvb, char* smem) {
  constexpr int CT = 24, NTL = 171;
  uint32_t* E0 = (uint32_t*)smem;
  uint32_t* E1 = E0 + 28 * 256;
  float* cv = (float*)smem;
  const int t = tid_opaque(), wave = t >> 6, lane = t & 63;
  const uint16_t* z = (const uint16_t*)(p.ws + WS_Z);
  uint16_t* mixed = (uint16_t*)(p.ws + WS_MIXED);
  const float* cw = p.in[8]; const float* cb = p.in[9]; const float* gl = p.in[10]; const float* bl = p.in[11];
  uint32_t wp0[16], wp1[16];
#pragma unroll
  for (int jp = 0; jp < 16; jp++) {
    const float2 wa = *(const float2*)(cw + (2 * jp) * 512 + 2 * t);
    float2 wb = make_float2(0.f, 0.f);
    if (jp < 15) wb = *(const float2*)(cw + (2 * jp + 1) * 512 + 2 * t);
    wp0[jp] = pk(wa.x, wb.x); wp1[jp] = pk(wa.y, wb.y);
  }
  const float bias0 = cb[2 * t], bias1 = cb[2 * t + 1];
  for (int tile = vb; tile < NBATCH * NTL; tile += nvb) {
    const int b = tile / NTL, t0 = NMETA + (tile - b * NTL) * CT;
    __syncthreads();
#pragma unroll 1
    for (int kb = 0; kb < 27; kb += 9) {
      uint32_t a2[18], b2[18];
#pragma unroll
      for (int u = 0; u < 18; u++) {
        const int tt = t0 - 30 + 2 * kb + u;
        const uint16_t* zr = z + (size_t)(b * TP + (tt < 0 ? 0 : tt)) * ZW;
        a2[u] = *(const uint32_t*)(zr + 2 * t); b2[u] = *(const uint32_t*)(zr + 512 + 2 * t);
      }
#pragma unroll
      for (int u = 0; u < 9; u++) {
        const int tt = t0 - 30 + 2 * (kb + u);
        float h00 = bflo(a2[2 * u]) * fast_sigmoid(bflo(b2[2 * u])), h01 = bfhi(a2[2 * u]) * fast_sigmoid(bfhi(b2[2 * u]));
        float h10 = bflo(a2[2 * u + 1]) * fast_sigmoid(bflo(b2[2 * u + 1])), h11 = bfhi(a2[2 * u + 1]) * fast_sigmoid(bfhi(b2[2 * u + 1]));
        if (tt < 0) { h00 = 0.f; h01 = 0.f; }
        if (tt + 1 < 0) { h10 = 0.f; h11 = 0.f; }
        E0[(kb + u) * 256 + t] = pk(h00, h10);
        E1[(kb + u) * 256 + t] = pk(h01, h11);
      }
    }
    E0[27 * 256 + t] = 0u; E1[27 * 256 + t] = 0u;
    float acc0[CT], acc1[CT];
#pragma unroll
    for (int ip = 0; ip < CT / 2; ip++) {
      float e0 = bias0, o0 = bias0, e1 = bias1, o1 = bias1;
      uint32_t pv0 = E0[ip * 256 + t], pv1 = E1[ip * 256 + t];
#pragma unroll
      for (int jp = 0; jp < 16; jp++) {
        const uint32_t nx0 = E0[(ip + jp + 1) * 256 + t], nx1 = E1[(ip + jp + 1) * 256 + t];
        e0 = dot2bf(pv0, wp0[jp], e0); e1 = dot2bf(pv1, wp1[jp], e1);
        o0 = dot2bf(__builtin_amdgcn_alignbyte(nx0, pv0, 2), wp0[jp], o0);
        o1 = dot2bf(__builtin_amdgcn_alignbyte(nx1, pv1, 2), wp1[jp], o1);
        pv0 = nx0; pv1 = nx1;
      }
      acc0[2 * ip] = e0; acc0[2 * ip + 1] = o0; acc1[2 * ip] = e1; acc1[2 * ip + 1] = o1;
    }
    __syncthreads();
#pragma unroll
    for (int i = 0; i < CT; i++) *(float2*)(cv + i * 512 + 2 * t) = make_float2(acc0[i], acc1[i]);
    __syncthreads();
    float gln[8], bln[8];
#pragma unroll
    for (int e = 0; e < 8; e++) { gln[e] = gl[lane * 8 + e]; bln[e] = bl[lane * 8 + e]; }
#pragma unroll 2
    for (int q = 0; q < CT / 4; q++) {
      const int tk = wave * (CT / 4) + q;
      float v[8];
      const float4 x0 = *(const float4*)(cv + tk * 512 + lane * 8), x1 = *(const float4*)(cv + tk * 512 + lane * 8 + 4);
      v[0] = x0.x; v[1] = x0.y; v[2] = x0.z; v[3] = x0.w; v[4] = x1.x; v[5] = x1.y; v[6] = x1.z; v[7] = x1.w;
      float s = 0.f;
#pragma unroll
      for (int e = 0; e < 8; e++) s += v[e];
      const float mu = wsum64(s) * (1.f / 512.f);
      float s2 = 0.f;
#pragma unroll
      for (int e = 0; e < 8; e++) { v[e] -= mu; s2 += v[e] * v[e]; }
      const float rstd = rsqrtf(wsum64(s2) * (1.f / 512.f) + EPS);
      float s3 = 0.f;
#pragma unroll
      for (int e = 0; e < 8; e++) {
        const float y = v[e] * rstd * gln[e] + bln[e];
        const float sl = y * fast_sigmoid(y);
        v[e] = sl; s3 += sl * sl;
      }
      const float r2 = rsqrtf(wsum64(s3) * (1.f / 512.f) + EPS);
      uint4 o = make_uint4(pk(v[0] * r2, v[1] * r2), pk(v[2] * r2, v[3] * r2), pk(v[4] * r2, v[5] * r2), pk(v[6] * r2, v[7] * r2));
      *(uint4*)(mixed + (size_t)(b * TP + t0 + tk) * 1024 + 512 + lane * 8) = o;
    }
  }
}

__device__ void phase_gemm_qkv(const P& p, int vb, int nvb, char* smem) {
  const int t = tid_opaque(), kc = t & 7, r0 = t >> 3;
  const float* Ct = (const float*)smem; const float* rs = (const float*)(smem + LDS_RS);
  const uint16_t* z = (const uint16_t*)(p.ws + WS_Z);
  uint16_t* Q = (uint16_t*)(p.ws + WS_Q); uint16_t* Kn = (uint16_t*)(p.ws + WS_KN); uint16_t* Vt = (uint16_t*)(p.ws + WS_VT);
  const float* cost = (const float*)(p.ws + WS_ROPE); const float* sint = cost + TP * 16;
  const bool az[4] = {false, false, false, false};
  for (int tile = vb; tile < 264 * 14; tile += nvb) {
    const int mt = tile / 14, nt = tile - mt * 14;
    const char* arow[4];
    if (nt < 6) {
#pragma unroll
      for (int i = 0; i < 4; i++) arow[i] = (const char*)(z + (size_t)(mt * 128 + r0 + 32 * i) * ZW + 1024);
      gemm_core<0, false, false, 256>(smem, arow, az, (const uint16_t*)(p.ws + WS_WT_UQ), nt * 128, nt);
      int te = threadIdx.x; asm volatile("" : "+v"(te)); const int c8 = te & 15, tq = te >> 4;
      const int gc = nt * 128 + c8 * 8; const int hd = gc / 96; const int d = gc - hd * 96;
#pragma unroll
      for (int i = 0; i < 8; i++) {
        const int r = tq + 16 * i; const float s = rs[r]; const int prow = mt * 128 + r;
        if (d < 64) {
          const float4 v0 = *(const float4*)(Ct + r * CT_LD + c8 * 8), v1 = *(const float4*)(Ct + r * CT_LD + c8 * 8 + 4);
          *(uint4*)(Q + (size_t)prow * 768 + gc) = make_uint4(pk(v0.x * s, v0.y * s), pk(v0.z * s, v0.w * s), pk(v1.x * s, v1.y * s), pk(v1.z * s, v1.w * s));
        } else if (d < 80) {
          const int pos = prow % TP; float o1[8], o2[8];
#pragma unroll
          for (int e = 0; e < 8; e++) {
            const int c = c8 * 8 + e; const int j = d - 64 + e;
            const float x1 = Ct[r * CT_LD + c] * s, x2 = Ct[r * CT_LD + c + 16] * s;
            const float cs = cost[pos * 16 + j], sn = sint[pos * 16 + j];
            o1[e] = x1 * cs - x2 * sn; o2[e] = x2 * cs + x1 * sn;
          }
          *(uint4*)(Q + (size_t)prow * 768 + gc) = make_uint4(pk(o1[0], o1[1]), pk(o1[2], o1[3]), pk(o1[4], o1[5]), pk(o1[6], o1[7]));
          *(uint4*)(Q + (size_t)prow * 768 + gc + 16) = make_uint4(pk(o2[0], o2[1]), pk(o2[2], o2[3]), pk(o2[4], o2[5]), pk(o2[6], o2[7]));
        }
      }
    } else if (nt < 10) {
      const int n0 = (nt - 6) * 128;
#pragma unroll
      for (int i = 0; i < 4; i++) arow[i] = (const char*)(z + (size_t)(mt * 128 + r0 + 32 * i) * ZW + 1280);
      gemm_core<0, false, false, 128>(smem, arow, az, (const uint16_t*)(p.ws + WS_WT_UK), n0, nt);
      int te = threadIdx.x; asm volatile("" : "+v"(te)); const int c8 = te & 15, tq = te >> 4;
#pragma unroll
      for (int i = 0; i < 8; i++) {
        const int r = tq + 16 * i; const float s = rs[r]; const int prow = mt * 128 + r;
        const float4 v0 = *(const float4*)(Ct + r * CT_LD + c8 * 8), v1 = *(const float4*)(Ct + r * CT_LD + c8 * 8 + 4);
        *(uint4*)(Kn + (size_t)prow * 512 + n0 + c8 * 8) = make_uint4(pk(v0.x * s, v0.y * s), pk(v0.z * s, v0.w * s), pk(v1.x * s, v1.y * s), pk(v1.z * s, v1.w * s));
      }
    } else {
      const int n0 = (nt - 10) * 128;
#pragma unroll
      for (int i = 0; i < 4; i++) arow[i] = (const char*)(z + (size_t)(mt * 128 + r0 + 32 * i) * ZW + 1280);
      gemm_core<0, true, false, 128>(smem, arow, az, (const uint16_t*)(p.ws + WS_WT_UV), n0, nt);
      int te = threadIdx.x; asm volatile("" : "+v"(te)); const int c8 = te & 15, tq = te >> 4;
      const int b = (mt * 128) / TP; const int tt0 = mt * 128 - b * TP;
      float sc[8];
#pragma unroll
      for (int e = 0; e < 8; e++) sc[e] = rs[c8 * 8 + e];
#pragma unroll
      for (int i = 0; i < 8; i++) {
        const int r = tq + 16 * i;
        const int n = n0 + r; const int hd = n >> 6, dv = n & 63;
        const float4 v0 = *(const float4*)(Ct + r * CT_LD + c8 * 8), v1 = *(const float4*)(Ct + r * CT_LD + c8 * 8 + 4);
        *(uint4*)(Vt + ((size_t)((b * 8 + hd) * 64 + dv)) * TP + tt0 + c8 * 8) =
            make_uint4(pk(v0.x * sc[0], v0.y * sc[1]), pk(v0.z * sc[2], v0.w * sc[3]), pk(v1.x * sc[4], v1.y * sc[5]), pk(v1.z * sc[6], v1.w * sc[7]));
      }
    }
  }
}

#if NAIVE_ATTN
__device__ void phase_attn(const P& p, int vb, int nvb, char* smem) {
  const uint16_t* Q = (const uint16_t*)(p.ws + WS_Q); const uint16_t* Kn = (const uint16_t*)(p.ws + WS_KN);
  const uint16_t* Vt = (const uint16_t*)(p.ws + WS_VT); const uint16_t* kr = (const uint16_t*)(p.ws + WS_KROPE);
  uint16_t* mixed = (uint16_t*)(p.ws + WS_MIXED);
  for (int item = vb; item < 64 * 17; item += nvb) {
    const int bh = item / 17, qc = item - bh * 17; const int b = bh >> 3, h = bh & 7;
    const int q = qc * 256 + threadIdx.x;
    const bool valid = q < TP; const int qq = valid ? q : TP - 1;
    float qv[96];
#pragma unroll
    for (int d = 0; d < 96; d++) qv[d] = bf1(Q[(size_t)(b * TP + qq) * 768 + h * 96 + d]);
    float o[64];
#pragma unroll
    for (int d = 0; d < 64; d++) o[d] = 0.f;
    float m = -INFINITY, l = 0.f;
    int kmax = qc * 256 + 255; if (kmax > TP - 1) kmax = TP - 1;
    for (int j = 0; j <= kmax; j++) {
      const uint16_t* kp = Kn + (size_t)(b * TP + j) * 512 + h * 64;
      const uint16_t* rp = kr + (size_t)(b * TP + j) * 32;
      float s = 0.f;
#pragma unroll
      for (int d = 0; d < 64; d++) s += qv[d] * bf1(kp[d]);
#pragma unroll
      for (int d = 0; d < 32; d++) s += qv[64 + d] * bf1(rp[d]);
      if (j > qq) s = -INFINITY;
      const float mn = fmaxf(m, s);
      const float alpha = exp2f(m - mn), pj = exp2f(s - mn);
      m = mn; l = l * alpha + pj;
      const uint16_t* vp = Vt + (size_t)((b * 8 + h) * 64) * TP + j;
#pragma unroll
      for (int d = 0; d < 64; d++) o[d] = o[d] * alpha + pj * bf1(vp[(size_t)d * TP]);
    }
    if (valid) {
      const float inv = 1.f / l;
      uint16_t* op = mixed + (size_t)(b * TP + q) * 1024 + h * 64;
#pragma unroll
      for (int d = 0; d < 64; d += 2) *(uint32_t*)(op + d) = pk(o[d] * inv, o[d + 1] * inv);
    }
  }
}
#endif

#if !NAIVE_ATTN
__device__ void phase_attn(const P& p, int vb, int nvb, char* smem) {
  const int t = tid_opaque(), wave = t >> 6, lane = t & 63, lr = lane & 31, lh = lane >> 5;
  const uint16_t* Q = (const uint16_t*)(p.ws + WS_Q); const uint16_t* Kn = (const uint16_t*)(p.ws + WS_KN);
  const uint16_t* Vt = (const uint16_t*)(p.ws + WS_VT); const uint16_t* kr = (const uint16_t*)(p.ws + WS_KROPE);
  uint16_t* mixed = (uint16_t*)(p.ws + WS_MIXED);
  constexpr int KP = 104, VP = 68;
  constexpr int KBYTES = 64 * KP * 2, BUFB = KBYTES + 64 * VP * 2;
  constexpr int NITEM = 64 * 33;
  if (vb & 1) convert_tables(p, vb, nvb);
  for (int rnd = 0; rnd * nvb < NITEM; rnd++) {
    const int it = (rnd & 1) ? rnd * nvb + (nvb - 1 - vb) : rnd * nvb + vb;
    if (it >= NITEM) continue;
    const int qb = 32 - (it >> 6), bh = it & 63, b = bh >> 3, h = bh & 7;
    const int q0 = qb * 128, nkt = 2 * qb + 2;
    const int qlo = q0 + 32 * wave, qrow = qlo + lr;
    const bool wreal = qlo < NMETA + SEQ;
    Frag qf[6];
#pragma unroll
    for (int s = 0; s < 6; s++) qf[s].q = *(const uint4*)(Q + (size_t)(b * TP + qrow) * 768 + h * 96 + 16 * s + 8 * lh);
    f32x16 o0, o1;
#pragma unroll
    for (int r = 0; r < 16; r++) { o0[r] = 0.f; o1[r] = 0.f; }
    float m = -INFINITY, l = 0.f;
    uint4 st0, st1, st2, st3, st4;
    const uint16_t* kbase = Kn + (size_t)(b * TP + (t >> 3)) * 512 + h * 64 + (t & 7) * 8;
    const uint16_t* rbase = kr + (size_t)(b * TP + (t >> 2)) * 32 + (t & 3) * 8;
    const uint16_t* vbase = Vt + ((size_t)((b * 8 + h) * 64 + (t >> 3))) * TP + (t & 7) * 8;
#define AT_LOAD(KT_)                                                    \
  {                                                                     \
    const int k0_ = (KT_) * 64;                                         \
    st0 = *(const uint4*)(kbase + (size_t)k0_ * 512);                   \
    st1 = *(const uint4*)(kbase + (size_t)(k0_ + 32) * 512);            \
    st2 = *(const uint4*)(rbase + (size_t)k0_ * 32);                    \
    st3 = *(const uint4*)(vbase + k0_);                                 \
    st4 = *(const uint4*)(vbase + (size_t)32 * TP + k0_);               \
  }
#define AT_STORE(BUF_)                                                                    \
  {                                                                                       \
    char* kl_ = smem + (BUF_) * BUFB; char* vl_ = kl_ + KBYTES;                           \
    *(uint4*)(kl_ + ((t >> 3) * KP + (t & 7) * 8) * 2) = st0;                             \
    *(uint4*)(kl_ + (((t >> 3) + 32) * KP + (t & 7) * 8) * 2) = st1;                      \
    *(uint4*)(kl_ + ((t >> 2) * KP + 64 + (t & 3) * 8) * 2) = st2;                        \
    *(uint4*)(vl_ + ((t >> 3) * VP + (t & 7) * 8) * 2) = st3;                             \
    *(uint4*)(vl_ + (((t >> 3) + 32) * VP + (t & 7) * 8) * 2) = st4;                      \
  }
    __syncthreads();
    AT_LOAD(0);
    AT_STORE(0);
    __syncthreads();
    for (int kt = 0; kt < nkt; kt++) {
      const int buf = kt & 1;
      if (kt + 1 < nkt) AT_LOAD(kt + 1);
      const int k0 = kt * 64;
      if (wreal && k0 <= qlo + 31) {
        const char* kl = smem + buf * BUFB; const char* vl = kl + KBYTES;
        f32x16 s0, s1;
#pragma unroll
        for (int r = 0; r < 16; r++) { s0[r] = 0.f; s1[r] = 0.f; }
#pragma unroll
        for (int s = 0; s < 6; s++) {
          const bf16x8 k0f = *(const bf16x8*)(kl + ((lr)*KP + 16 * s + 8 * lh) * 2);
          const bf16x8 k1f = *(const bf16x8*)(kl + ((32 + lr) * KP + 16 * s + 8 * lh) * 2);
          s0 = __builtin_amdgcn_mfma_f32_32x32x16_bf16(k0f, qf[s].v, s0, 0, 0, 0);
          s1 = __builtin_amdgcn_mfma_f32_32x32x16_bf16(k1f, qf[s].v, s1, 0, 0, 0);
        }
        if (k0 + 63 > qlo) {
#pragma unroll
          for (int r = 0; r < 16; r++) {
            const int key = k0 + (r & 3) + 8 * (r >> 2) + 4 * lh;
            if (key > qrow) s0[r] = -INFINITY;
            if (key + 32 > qrow) s1[r] = -INFINITY;
          }
        }
        float mxa = __builtin_fmaxf(__builtin_fmaxf(s0[0], s0[1]), s0[2]);
        float mxb = __builtin_fmaxf(__builtin_fmaxf(s1[0], s1[1]), s1[2]);
#pragma unroll
        for (int r = 3; r < 15; r += 2) {
          mxa = __builtin_fmaxf(__builtin_fmaxf(mxa, s0[r]), s0[r + 1]);
          mxb = __builtin_fmaxf(__builtin_fmaxf(mxb, s1[r]), s1[r + 1]);
        }
        float mx = __builtin_fmaxf(__builtin_fmaxf(mxa, s0[15]), __builtin_fmaxf(mxb, s1[15]));
        mx = fmaxf(mx, __shfl_xor(mx, 32));
        const float mn = fmaxf(m, mx);
        const float alpha = __builtin_amdgcn_exp2f(m - mn);
        m = mn;
        float psum = 0.f;
#pragma unroll
        for (int r = 0; r < 16; r++) {
          s0[r] = __builtin_amdgcn_exp2f(s0[r] - mn); s1[r] = __builtin_amdgcn_exp2f(s1[r] - mn);
          psum += s0[r] + s1[r];
        }
        l = l * alpha + psum;
        o0 *= alpha; o1 *= alpha;
#pragma unroll
        for (int kk = 0; kk < 2; kk++)
#pragma unroll
          for (int s2 = 0; s2 < 2; s2++) {
            Frag pf;
#pragma unroll
            for (int e = 0; e < 4; e++) pf.u[e] = kk == 0 ? pk(s0[8 * s2 + 2 * e], s0[8 * s2 + 2 * e + 1]) : pk(s1[8 * s2 + 2 * e], s1[8 * s2 + 2 * e + 1]);
            Frag v0f, v1f;
            const char* vp0 = vl + ((lr)*VP + 32 * kk + 16 * s2 + 4 * lh) * 2;
            const char* vp1 = vl + ((32 + lr) * VP + 32 * kk + 16 * s2 + 4 * lh) * 2;
            v0f.d[0] = *(const uint2*)vp0; v0f.d[1] = *(const uint2*)(vp0 + 16);
            v1f.d[0] = *(const uint2*)vp1; v1f.d[1] = *(const uint2*)(vp1 + 16);
            o0 = __builtin_amdgcn_mfma_f32_32x32x16_bf16(v0f.v, pf.v, o0, 0, 0, 0);
            o1 = __builtin_amdgcn_mfma_f32_32x32x16_bf16(v1f.v, pf.v, o1, 0, 0, 0);
          }
      }
      if (kt + 1 < nkt) AT_STORE(buf ^ 1);
      __syncthreads();
    }
    if (wreal) {
      const float lt = l + __shfl_xor(l, 32);
      const float inv = 1.f / lt;
      uint16_t* op = mixed + (size_t)(b * TP + qrow) * 1024 + h * 64 + 4 * lh;
#pragma unroll
      for (int rg = 0; rg < 4; rg++) {
        *(uint2*)(op + 8 * rg) = make_uint2(pk(o0[4 * rg] * inv, o0[4 * rg + 1] * inv), pk(o0[4 * rg + 2] * inv, o0[4 * rg + 3] * inv));
        *(uint2*)(op + 32 + 8 * rg) = make_uint2(pk(o1[4 * rg] * inv, o1[4 * rg + 1] * inv), pk(o1[4 * rg + 2] * inv, o1[4 * rg + 3] * inv));
      }
    }
  }
  if (!(vb & 1)) convert_tables(p, vb, nvb);
}
#endif

DEVI int prow_of(int rr) { return (rr >> 12) * TP + NMETA + (rr & 4095); }

__device__ void phase_gemm_out(const P& p, int vb, int nvb, char* smem, int var = 0) {
  const int t = tid_opaque(), r0 = t >> 3, c8 = t & 15;
  const float* Ct = (const float*)smem;
  const uint16_t* mixed = (const uint16_t*)(p.ws + WS_MIXED);
  float* h2 = (float*)(p.ws + WS_H2);
  const bool az[4] = {false, false, false, false};
  const bool xs = (nvb & 7) == 0;
  const int xcd = vb & 7, slot = vb >> 3, nslot = nvb >> 3;
  for (int li = xs ? slot : vb; li < (xs ? 32 * 8 : 256 * 8); li += (xs ? nslot : nvb)) {
    const int mt = xs ? (li >> 3) * 8 + xcd : li >> 3, nt = li & 7;
    const char* arow[4];
#pragma unroll
    for (int i = 0; i < 4; i++) arow[i] = (const char*)(mixed + (size_t)prow_of(mt * 128 + (var == 3 ? 0 : r0 + 32 * i)) * 1024);
    gemm_core<0, false, true, 1024>(smem, arow, az, (const uint16_t*)(p.ws + WS_WT_OUT), nt * 128, nt, var >= 2 ? 0 : 0xffff, var == 3 ? 0 : 1);
    if (var != 0) continue;
#pragma unroll
    for (int i = 0; i < 8; i++) {
      const int r = (t >> 4) + 16 * i; const int rr = mt * 128 + r;
      const float* xr = p.in[0] + (size_t)rr * DM + nt * 128 + c8 * 8;
      const float4 x0 = *(const float4*)xr, x1 = *(const float4*)(xr + 4);
      const float4 v0 = *(const float4*)(Ct + r * CT_LD + c8 * 8), v1 = *(const float4*)(Ct + r * CT_LD + c8 * 8 + 4);
      const float4 y0 = make_float4(x0.x + v0.x, x0.y + v0.y, x0.z + v0.z, x0.w + v0.w);
      const float4 y1 = make_float4(x1.x + v1.x, x1.y + v1.y, x1.z + v1.z, x1.w + v1.w);
      *(uint4*)(p.ws + WS_HB + ((size_t)rr * DM + nt * 128 + c8 * 8) * 2) = make_uint4(pk(y0.x, y0.y), pk(y0.z, y0.w), pk(y1.x, y1.y), pk(y1.z, y1.w));
      if (i & 1) __builtin_amdgcn_sched_barrier(0);
    }
  }
}

__device__ void phase_peer_q(const P& p, int vb, int nvb, char* smem) {
  const int t = tid_opaque(), r0 = t >> 3, wave = t >> 6, lane = t & 63, lr = lane & 31, lh = lane >> 5;
  float* Ct = (float*)smem; const float* rs = (const float*)(smem + LDS_RS);
  const float* h2 = (const float*)(p.ws + WS_H2);
  const uint16_t* keys = (const uint16_t*)(p.ws + WS_KEYS);
  int* seli = (int*)(p.ws + WS_SELI); float* selg = (float*)(p.ws + WS_SELG);
  const bool az[4] = {false, false, false, false};
  const bool xs = (nvb & 7) == 0;
  const int xcd = vb & 7, slot = vb >> 3, nslot = nvb >> 3;
  for (int li = xs ? slot : vb; li < (xs ? 32 * 8 : 256 * 8); li += (xs ? nslot : nvb)) {
    const int mt = xs ? (li >> 3) * 8 + xcd : li >> 3, hd = li & 7;
    const char* arow[4];
#pragma unroll
    for (int i = 0; i < 4; i++) arow[i] = p.ws + WS_HB + (size_t)(mt * 128 + r0 + 32 * i) * 2048;
    gemm_core<0, false, false, 1024>(smem, arow, az, (const uint16_t*)(p.ws + WS_WT_PQ), hd * 128, hd * 2);
    const int t2 = tid_opaque();
    const int wave2 = t2 >> 6, lr2 = t2 & 31, lh2 = (t2 >> 5) & 1;
    {
      const int r = t2 >> 1, c0 = (t2 & 1) * 64; const float rsv = rs[r];
      float4 tmp[16];
#pragma unroll
      for (int c = 0; c < 16; c++) tmp[c] = *(const float4*)(Ct + r * CT_LD + c0 + c * 4);
      __syncthreads();
      uint32_t* qrow = (uint32_t*)(smem + r * 272 + c0 * 2);
#pragma unroll
      for (int c = 0; c < 16; c++) { qrow[c * 2] = pk(tmp[c].x * rsv, tmp[c].y * rsv); qrow[c * 2 + 1] = pk(tmp[c].z * rsv, tmp[c].w * rsv); }
      __syncthreads();
    }
    uint32_t* svl = (uint32_t*)(smem + 34816);
    {
      const int tk = wave2 * 32 + lr2; const int rr = mt * 128 + tk;
      uint32_t sv0[16], sv1[16];
#pragma unroll 1
      for (int pp = 0; pp < 2; pp++) {
        f32x16 sc[4];
#pragma unroll
        for (int nt = 0; nt < 4; nt++)
#pragma unroll
          for (int r = 0; r < 16; r++) sc[nt][r] = 0.f;
#pragma unroll
        for (int ks = 0; ks < 4; ks++) {
          Frag qfr; qfr.q = *(const uint4*)(smem + tk * 272 + (pp * 64 + 16 * ks + 8 * lh2) * 2);
#pragma unroll
          for (int nt = 0; nt < 4; nt++) {
            Frag kf; kf.q = *(const uint4*)(keys + ((size_t)((hd * 2 + pp) * 128 + 32 * nt + lr2)) * 64 + 16 * ks + 8 * lh2);
            sc[nt] = __builtin_amdgcn_mfma_f32_32x32x16_bf16(kf.v, qfr.v, sc[nt], 0, 0, 0);
          }
          if (ks & 1) __builtin_amdgcn_sched_barrier(0);
        }
        uint32_t g0[16], g1[16], g2[16], g3[16];
#pragma unroll
        for (int r = 0; r < 16; r++) {
          const uint32_t n = (uint32_t)((r & 3) + 8 * (r >> 2) + 4 * lh2);
          g0[r] = (f2sort(sc[0][r]) & ~127u) | n;
          g1[r] = (f2sort(sc[1][r]) & ~127u) | (n + 32u);
          g2[r] = (f2sort(sc[2][r]) & ~127u) | (n + 64u);
          g3[r] = (f2sort(sc[3][r]) & ~127u) | (n + 96u);
        }
        __builtin_amdgcn_sched_barrier(0);
        sort16_desc(g0); sort16_desc(g1);
        __builtin_amdgcn_sched_barrier(0);
        sort16_desc(g2); sort16_desc(g3);
        __builtin_amdgcn_sched_barrier(0);
        merge16_desc(g0, g1); merge16_desc(g2, g3); merge16_desc(g0, g2);
        uint32_t y[16];
#pragma unroll
        for (int e = 0; e < 16; e++) y[e] = (uint32_t)__shfl_xor((int)g0[e], 32);
        merge16_desc(g0, y);
        {
          uint32_t* dst = svl + tk * 32 + pp * 16;
#pragma unroll
          for (int e = 0; e < 16; e += 4) *(uint4*)(dst + e) = make_uint4(g0[e], g0[e + 1], g0[e + 2], g0[e + 3]);
        }
      }
      asm volatile("s_waitcnt lgkmcnt(0)" ::: "memory");
#pragma unroll
      for (int e = 0; e < 16; e += 4) {
        const uint4 a0 = *(const uint4*)(svl + tk * 32 + e), a1 = *(const uint4*)(svl + tk * 32 + 16 + e);
        sv0[e] = a0.x; sv0[e + 1] = a0.y; sv0[e + 2] = a0.z; sv0[e + 3] = a0.w;
        sv1[e] = a1.x; sv1[e + 1] = a1.y; sv1[e + 2] = a1.z; sv1[e + 3] = a1.w;
      }
      __builtin_amdgcn_sched_barrier(0);
      float f0[16], f1[16];
#pragma unroll
      for (int e = 0; e < 16; e++) { f0[e] = sort2f(sv0[e] & ~127u); f1[e] = sort2f(sv1[e] & ~127u); }
      uint32_t c[32];
#define CPK(V_, C_) ((f2sort(V_) & ~255u) | (C_))
      c[0] = lh2 ? CPK(f0[2] + f1[1], 33u) : CPK(f0[0] + f1[0], 0u);
      c[1] = lh2 ? CPK(f0[2] + f1[2], 34u) : CPK(f0[0] + f1[1], 1u);
      c[2] = lh2 ? CPK(f0[2] + f1[3], 35u) : CPK(f0[0] + f1[2], 2u);
      c[3] = lh2 ? CPK(f0[2] + f1[4], 36u) : CPK(f0[0] + f1[3], 3u);
      c[4] = lh2 ? CPK(f0[3] + f1[0], 48u) : CPK(f0[0] + f1[4], 4u);
      c[5] = lh2 ? CPK(f0[3] + f1[1], 49u) : CPK(f0[0] + f1[5], 5u);
      c[6] = lh2 ? CPK(f0[3] + f1[2], 50u) : CPK(f0[0] + f1[6], 6u);
      c[7] = lh2 ? CPK(f0[3] + f1[3], 51u) : CPK(f0[0] + f1[7], 7u);
      c[8] = lh2 ? CPK(f0[4] + f1[0], 64u) : CPK(f0[0] + f1[8], 8u);
      c[9] = lh2 ? CPK(f0[4] + f1[1], 65u) : CPK(f0[0] + f1[9], 9u);
      c[10] = lh2 ? CPK(f0[4] + f1[2], 66u) : CPK(f0[0] + f1[10], 10u);
      c[11] = lh2 ? CPK(f0[5] + f1[0], 80u) : CPK(f0[0] + f1[11], 11u);
      c[12] = lh2 ? CPK(f0[5] + f1[1], 81u) : CPK(f0[0] + f1[12], 12u);
      c[13] = lh2 ? CPK(f0[6] + f1[0], 96u) : CPK(f0[0] + f1[13], 13u);
      c[14] = lh2 ? CPK(f0[6] + f1[1], 97u) : CPK(f0[0] + f1[14], 14u);
      c[15] = lh2 ? CPK(f0[7] + f1[0], 112u) : CPK(f0[0] + f1[15], 15u);
      c[16] = lh2 ? CPK(f0[7] + f1[1], 113u) : CPK(f0[1] + f1[0], 16u);
      c[17] = lh2 ? CPK(f0[8] + f1[0], 128u) : CPK(f0[1] + f1[1], 17u);
      c[18] = lh2 ? CPK(f0[9] + f1[0], 144u) : CPK(f0[1] + f1[2], 18u);
      c[19] = lh2 ? CPK(f0[10] + f1[0], 160u) : CPK(f0[1] + f1[3], 19u);
      c[20] = lh2 ? CPK(f0[11] + f1[0], 176u) : CPK(f0[1] + f1[4], 20u);
      c[21] = lh2 ? CPK(f0[12] + f1[0], 192u) : CPK(f0[1] + f1[5], 21u);
      c[22] = lh2 ? CPK(f0[13] + f1[0], 208u) : CPK(f0[1] + f1[6], 22u);
      c[23] = lh2 ? CPK(f0[14] + f1[0], 224u) : CPK(f0[1] + f1[7], 23u);
      c[24] = lh2 ? CPK(f0[15] + f1[0], 240u) : CPK(f0[2] + f1[0], 32u);
      c[25] = 0xff800000u;
      c[26] = 0xff800000u;
      c[27] = 0xff800000u;
      c[28] = 0xff800000u;
      c[29] = 0xff800000u;
      c[30] = 0xff800000u;
      c[31] = 0xff800000u;
#undef CPK
      __builtin_amdgcn_sched_barrier(0);
      uint32_t ca[16], cb[16];
#pragma unroll
      for (int e = 0; e < 16; e++) { ca[e] = c[e]; cb[e] = c[16 + e]; }
      sort16_desc(ca); sort16_desc(cb); merge16_desc(ca, cb);
#pragma unroll
      for (int e = 0; e < 16; e++) cb[e] = (uint32_t)__shfl_xor((int)ca[e], 32);
      merge16_desc(ca, cb);
      __builtin_amdgcn_sched_barrier(0);
      const float vfirst = sort2f(ca[0] & ~255u);
      float ev[16]; float esum = 0.f;
#pragma unroll
      for (int e = 0; e < 16; e++) { ev[e] = __expf(sort2f(ca[e] & ~255u) - vfirst); esum += ev[e]; }
      const float einv = 1.f / esum;
      int eo[8]; float go[8];
      const uint32_t hmask = lh2 ? 0xffffffffu : 0u;
#pragma unroll
      for (int e = 0; e < 8; e++) {
        const uint32_t key = ca[e] ^ ((ca[e] ^ ca[8 + e]) & hmask);
        const int cc = (int)(key & 255u); const int i = cc >> 4, j = cc & 15;
        eo[e] = (int)(svl[tk * 32 + i] & 127u) * 128 + (int)(svl[tk * 32 + 16 + j] & 127u);
        go[e] = __uint_as_float(__float_as_uint(ev[e]) ^ ((__float_as_uint(ev[e]) ^ __float_as_uint(ev[8 + e])) & hmask)) * einv;
      }
      int* ip = seli + (size_t)rr * 128 + hd * 16 + 8 * lh2; float* gp = selg + (size_t)rr * 128 + hd * 16 + 8 * lh2;
      *(int4*)ip = make_int4(eo[0], eo[1], eo[2], eo[3]); *(int4*)(ip + 4) = make_int4(eo[4], eo[5], eo[6], eo[7]);
      *(float4*)gp = make_float4(go[0], go[1], go[2], go[3]); *(float4*)(gp + 4) = make_float4(go[4], go[5], go[6], go[7]);
    }
  }
}

DEVI float gelu_exact(float x) { return 0.5f * x * (1.f + erff(x * 0.70710678118654752f)); }

typedef float f32x2 __attribute__((ext_vector_type(2)));
DEVI float4 ldbf4(const uint16_t* p) { const uint2 v = *(const uint2*)p; return make_float4(bflo(v.x), bfhi(v.x), bflo(v.y), bfhi(v.y)); }
__device__ void phase_gather(const P& p, int vb, int nvb, char* smem) {
  const int t = tid_opaque(), wave = t >> 6, lane = t & 63, g = lane >> 4, j = lane & 15;
  const uint16_t* h2 = (const uint16_t*)(p.ws + WS_HB);
  const int* seli = (const int*)(p.ws + WS_SELI); const float* selg = (const float*)(p.ws + WS_SELG);
  const uint8_t* U = (const uint8_t*)(p.ws + WS_U8); const uint8_t* V = (const uint8_t*)(p.ws + WS_V8);
  const float* gf = p.in[15]; const float* gfin = p.in[20];
  uint32_t* kl = (uint32_t*)smem + wave * 1024;
  float* wl = (float*)(kl + 512);
  for (int base = (vb * 4 + wave) * 4; base < NREAL; base += nvb * 16) {
    const int rr = base + g;
    const uint16_t* hr = h2 + (size_t)rr * DM;
    f32x2 xf[32];
    {
      float ss = 0.f;
#pragma unroll
      for (int i = 0; i < 4; i++)
#pragma unroll
        for (int q = 0; q < 4; q++) {
          const float4 a = ldbf4(hr + i * 256 + 16 * j + 4 * q);
          ss += a.x * a.x + a.y * a.y + a.z * a.z + a.w * a.w;
        }
      const float rstd = rsqrtf(wsum16(ss) * (1.f / 1024.f) + EPS);
#pragma unroll
      for (int i = 0; i < 4; i++) {
#pragma unroll
        for (int q = 0; q < 4; q++) {
          const float4 a = ldbf4(hr + i * 256 + 16 * j + 4 * q);
          const float4 ga = *(const float4*)(gf + i * 256 + 16 * j + 4 * q);
          xf[i * 8 + q * 2 + 0] = f32x2{bf1((uint16_t)f2bf(a.x * rstd * ga.x)), bf1((uint16_t)f2bf(a.y * rstd * ga.y))};
          xf[i * 8 + q * 2 + 1] = f32x2{bf1((uint16_t)f2bf(a.z * rstd * ga.z)), bf1((uint16_t)f2bf(a.w * rstd * ga.w))};
        }
        __builtin_amdgcn_sched_barrier(0);
      }
    }
    {
      uint32_t ks[8];
      {
        const int4 a0 = *(const int4*)(seli + (size_t)rr * 128 + j * 8), a1 = *(const int4*)(seli + (size_t)rr * 128 + j * 8 + 4);
        const int ev[8] = {a0.x, a0.y, a0.z, a0.w, a1.x, a1.y, a1.z, a1.w};
#pragma unroll
        for (int r = 0; r < 8; r++) ks[r] = ((uint32_t)ev[r] << 7) | (uint32_t)(j * 8 + r);
      }
#pragma unroll
      for (int k = 2; k <= 128; k <<= 1) {
#pragma unroll
        for (int d = k >> 1; d > 0; d >>= 1) {
          if (d >= 8) {
#pragma unroll
            for (int r = 0; r < 8; r++) {
              const uint32_t o = (uint32_t)__shfl_xor((int)ks[r], d >> 3);
              const bool up = (((j * 8 + r) & k) == 0), lower = (((j * 8) & d) == 0);
              const uint32_t mn = ks[r] < o ? ks[r] : o, mx = ks[r] < o ? o : ks[r];
              ks[r] = (lower == up) ? mn : mx;
            }
          } else {
#pragma unroll
            for (int r = 0; r < 8; r++) {
              if ((r & d) == 0) {
                const bool up = (((j * 8 + r) & k) == 0);
                const uint32_t x0 = ks[r], x1 = ks[r | d];
                const uint32_t mn = x0 < x1 ? x0 : x1, mx = x0 < x1 ? x1 : x0;
                ks[r] = up ? mn : mx; ks[r | d] = up ? mx : mn;
              }
            }
          }
        }
      }
      *(uint4*)(kl + g * 128 + j * 8) = make_uint4(ks[0], ks[1], ks[2], ks[3]);
      *(uint4*)(kl + g * 128 + j * 8 + 4) = make_uint4(ks[4], ks[5], ks[6], ks[7]);
    }
    asm volatile("s_waitcnt lgkmcnt(0)" ::: "memory");
    const float* sgp = selg + (size_t)rr * 128;
    const uint32_t* mykl = kl + g * 128;
    float* mywl = wl + g * 128;
#pragma unroll 1
    for (int b0 = 0; b0 < 128; b0 += 8) {
      float dp[8];
#pragma unroll
      for (int u = 0; u < 8; u++) {
        const uint32_t key = mykl[b0 + u];
        const int e = (int)(key >> 7);
        const uint4* up = (const uint4*)(U + (size_t)e * 1024 + 16 * j);
        uint4 uu[4];
#pragma unroll
        for (int i = 0; i < 4; i++) uu[i] = up[i * 16];
        f32x2 d2 = f32x2{0.f, 0.f};
#pragma unroll
        for (int i = 0; i < 4; i++) {
          const uint32_t w[4] = {uu[i].x, uu[i].y, uu[i].z, uu[i].w};
#pragma unroll
          for (int q = 0; q < 4; q++) {
            d2 += __builtin_amdgcn_cvt_pk_f32_fp8((int)w[q], false) * xf[i * 8 + q * 2 + 0];
            d2 += __builtin_amdgcn_cvt_pk_f32_fp8((int)w[q], true) * xf[i * 8 + q * 2 + 1];
          }
        }
        dp[u] = d2.x + d2.y;
      }
      const bool h8 = (j & 8) != 0, h4 = (j & 4) != 0, h2b = (j & 2) != 0;
      float q4[4], q2[2];
#pragma unroll
      for (int k = 0; k < 4; k++) { const float snd = h8 ? dp[k] : dp[k + 4], kp = h8 ? dp[k + 4] : dp[k]; q4[k] = kp + __shfl_xor(snd, 8); }
#pragma unroll
      for (int k = 0; k < 2; k++) { const float snd = h4 ? q4[k] : q4[k + 2], kp = h4 ? q4[k + 2] : q4[k]; q2[k] = kp + __shfl_xor(snd, 4); }
      const float snd1 = h2b ? q2[0] : q2[1], kp1 = h2b ? q2[1] : q2[0];
      float q1 = kp1 + __shfl_xor(snd1, 2);
      q1 += __shfl_xor(q1, 1);
      if ((j & 1) == 0) mywl[b0 + (j >> 1)] = q1;
    }
    asm volatile("s_waitcnt lgkmcnt(0)" ::: "memory");
#pragma unroll
    for (int m = 0; m < 8; m++) {
      const int bb = j + 16 * m;
      const uint32_t key = mykl[bb];
      const float d = mywl[bb] * (1.f / USCALE);
      mywl[bb] = sgp[key & 127u] * gelu_exact(d) * (1.f / VSCALE);
    }
    asm volatile("s_waitcnt lgkmcnt(0)" ::: "memory");
    f32x2 acc[32];
#pragma unroll
    for (int i = 0; i < 32; i++) acc[i] = f32x2{0.f, 0.f};
#pragma unroll 8
    for (int bb = 0; bb < 128; bb++) {
      const uint32_t key = mykl[bb];
      const int e = (int)(key >> 7);
      const float wgt = mywl[bb];
      const uint4* vp = (const uint4*)(V + (size_t)e * 1024 + 16 * j);
      uint4 vv[4];
#pragma unroll
      for (int i = 0; i < 4; i++) vv[i] = vp[i * 16];
      const f32x2 w2 = f32x2{wgt, wgt};
#pragma unroll
      for (int i = 0; i < 4; i++) {
        const uint32_t w[4] = {vv[i].x, vv[i].y, vv[i].z, vv[i].w};
#pragma unroll
        for (int q = 0; q < 4; q++) {
          acc[i * 8 + q * 2 + 0] += w2 * __builtin_amdgcn_cvt_pk_f32_fp8((int)w[q], false);
          acc[i * 8 + q * 2 + 1] += w2 * __builtin_amdgcn_cvt_pk_f32_fp8((int)w[q], true);
        }
      }
    }
    asm volatile("" ::: "memory");
    float ss = 0.f;
#pragma unroll
    for (int i = 0; i < 4; i++) {
#pragma unroll
      for (int q = 0; q < 4; q++) {
        const float4 a = ldbf4(hr + i * 256 + 16 * j + 4 * q);
        const float v0 = acc[i * 8 + q * 2].x + a.x, v1 = acc[i * 8 + q * 2].y + a.y, v2 = acc[i * 8 + q * 2 + 1].x + a.z, v3 = acc[i * 8 + q * 2 + 1].y + a.w;
        acc[i * 8 + q * 2] = f32x2{v0, v1}; acc[i * 8 + q * 2 + 1] = f32x2{v2, v3};
        ss += v0 * v0 + v1 * v1 + v2 * v2 + v3 * v3;
      }
      __builtin_amdgcn_sched_barrier(0);
    }
    const float rstd = rsqrtf(wsum16(ss) * (1.f / 1024.f) + EPS);
    float* orow = p.out + (size_t)rr * DM;
#pragma unroll
    for (int i = 0; i < 4; i++) {
#pragma unroll
      for (int q = 0; q < 4; q++) {
        const float4 ga = *(const float4*)(gfin + i * 256 + 16 * j + 4 * q);
        *(float4*)(orow + i * 256 + 16 * j + 4 * q) =
            make_float4(acc[i * 8 + q * 2].x * rstd * ga.x, acc[i * 8 + q * 2].y * rstd * ga.y, acc[i * 8 + q * 2 + 1].x * rstd * ga.z, acc[i * 8 + q * 2 + 1].y * rstd * ga.w);
      }
      __builtin_amdgcn_sched_barrier(0);
    }
  }
}

#define XB_TMO      128
#define XB_XCNT(j)  (256  + 64 * (j))
#define XB_XSUB(j)  (1280 + 64 * (j))
#define XB_XGEN(j)  (2304 + 64 * (j))
#define XB_TOP      3328
#define XB_TOPGEN   3392
#define XCD_BAR_WORDS 3456
#define XB_SPIN_CAP (1u << 18)
#define LAS __attribute__((address_space(3)))

__device__ __forceinline__ unsigned xb_ld(unsigned* p)              { return __hip_atomic_load(p, __ATOMIC_RELAXED, __HIP_MEMORY_SCOPE_AGENT); }
__device__ __forceinline__ unsigned xb_add(unsigned* p, unsigned v) { return __hip_atomic_fetch_add(p, v, __ATOMIC_RELAXED, __HIP_MEMORY_SCOPE_AGENT); }
__device__ __forceinline__ unsigned xb_xcc_id() { return (unsigned)__builtin_amdgcn_s_getreg((3 << 11) | 20) & 0xFu; }
#define XB_SPIN(cond, bar) do { unsigned _sp = 0; while (cond) { __builtin_amdgcn_s_sleep(1); \
    if ((++_sp & 255u) == 0u) { if (xb_ld(&(bar)[XB_TMO])) break; if (_sp > XB_SPIN_CAP) { atomicAdd(&(bar)[XB_TMO], 1u); break; } } } } while (0)

struct XcdBarrier {
    unsigned* bar; unsigned x;
    volatile LAS unsigned* st;
};

__device__ __forceinline__ XcdBarrier xcd_barrier_post(unsigned* bar, volatile LAS unsigned* st) {
    XcdBarrier b; b.bar = bar; b.x = xb_xcc_id(); b.st = st;
    if (threadIdx.x == 0) (void)xb_add(&bar[XB_XCNT(b.x)], 1u);
    return b;
}
__device__ __forceinline__ void xcd_barrier_complete(unsigned* bar, unsigned x, unsigned& nloc, unsigned& nx) {
    const unsigned G = gridDim.x * gridDim.y * gridDim.z;
    unsigned sum, cnt, mine, sp = 0u;
    for (;;) {
        sum = 0u; cnt = 0u; mine = 0u;
#pragma unroll
        for (unsigned j = 0; j < 16; ++j) { const unsigned c = xb_ld(&bar[XB_XCNT(j)]); sum += c; cnt += (c > 0u) ? 1u : 0u; mine = (j == x) ? c : mine; }
        if (sum == G) break;
        __builtin_amdgcn_s_sleep(1);
        if ((++sp & 255u) == 0u) { if (xb_ld(&bar[XB_TMO])) break; if (sp > XB_SPIN_CAP) { atomicAdd(&bar[XB_TMO], 1u); break; } }
    }
    nloc = mine > 0u ? mine : 1u; nx = cnt > 0u ? cnt : 1u;
}

__device__ __forceinline__ void xcd_barrier(const XcdBarrier& b) {
    asm volatile("s_waitcnt vmcnt(0)" ::: "memory");
    __syncthreads();
    if (threadIdx.x == 0) {
        unsigned* bar = b.bar;
        __builtin_amdgcn_s_waitcnt(0);
        unsigned nloc = b.st[0], nx = b.st[1];
        if (nloc == 0u) { xcd_barrier_complete(bar, b.x, nloc, nx); b.st[0] = nloc; b.st[1] = nx; }
        const unsigned old = xb_add(&bar[XB_XSUB(b.x)], 1u);
        const unsigned gen = old / nloc;
        if (old + 1u == (gen + 1u) * nloc) {
            __builtin_amdgcn_fence(__ATOMIC_RELEASE, "agent");
            asm volatile("s_waitcnt vmcnt(0)" ::: "memory");
            const unsigned og = xb_add(&bar[XB_TOP], 1u);
            const unsigned tg = og / nx;
            if (og + 1u == (tg + 1u) * nx) xb_add(&bar[XB_TOPGEN], 1u);
            else XB_SPIN(xb_ld(&bar[XB_TOPGEN]) == tg, bar);
            __builtin_amdgcn_fence(__ATOMIC_ACQUIRE, "agent");
            xb_add(&bar[XB_XGEN(b.x)], 1u);
            asm volatile("s_waitcnt vmcnt(0)" ::: "memory");
        } else {
            XB_SPIN(xb_ld(&bar[XB_XGEN(b.x)]) == gen, bar);
            __builtin_amdgcn_fence(__ATOMIC_ACQUIRE, "agent");
            asm volatile("s_waitcnt vmcnt(0)" ::: "memory");
        }
    }
    __syncthreads();
}

constexpr int NPHASE = 8;
template <int PH> DEVI void run_phase(const P& p, int vb, int nvb, char* smem, int var = 0) {
  if (PH == 0) phase_prep(p, vb, nvb);
  if (PH == 1) phase_gemm_z(p, vb, nvb, smem);
  if (PH == 2) phase_conv(p, vb, nvb, smem);
  if (PH == 3) phase_gemm_qkv(p, vb, nvb, smem);
  if (PH == 4) phase_attn(p, vb, nvb, smem);
  if (PH == 5) phase_gemm_out(p, vb, nvb, smem, var);
  if (PH == 6) phase_peer_q(p, vb, nvb, smem);
  if (PH == 7) phase_gather(p, vb, nvb, smem);
}
template <int PH> __global__ void __launch_bounds__(256, 2) k_phase(P p) {
  extern __shared__ __attribute__((aligned(16))) char smem[];
  run_phase<PH>(p, blockIdx.x, gridDim.x, smem);
}
#if MEGA
#ifndef PROBE_DUP
#define PROBE_DUP -1
#endif
#ifndef PROBE_VAR
#define PROBE_VAR 0
#endif
#define RUN_PH(N, SYNC)                                                    \
  _Pragma("unroll 1") for (int rep_ = 0; rep_ < (PROBE_DUP == N ? 2 : 1); rep_++) { \
    run_phase<N>(p, vb, nvb, smem, rep_ == 0 ? 0 : PROBE_VAR);             \
    if (SYNC || rep_ + 1 < (PROBE_DUP == N ? 2 : 1)) { if (N == 0) grid.sync(); else xcd_barrier(xb); } \
  }
__global__ void __launch_bounds__(256, 2) k_main(P p) {
  extern __shared__ __attribute__((aligned(16))) char smem[];
  const int vb = blockIdx.x, nvb = gridDim.x;
  cg::grid_group grid = cg::this_grid();
  __shared__ uint4 xb_words;
  if (threadIdx.x == 0) xb_words = make_uint4(0u, 0u, 0u, 0u);
  __syncthreads();
  const XcdBarrier xb = xcd_barrier_post((unsigned*)(p.ws + WS_BAR), (volatile LAS unsigned*)&xb_words);
  RUN_PH(0, true)
  RUN_PH(1, true)
  RUN_PH(2, (PROBE_DUP == 2))
  RUN_PH(3, true)
  RUN_PH(4, true)
  RUN_PH(5, true)
  RUN_PH(6, true)
  RUN_PH(7, false)
}
#endif

template <int PH> static void launch_phase(const P& p, int nblk, hipStream_t stream) {
  static bool attr = false;
  if (!attr) { (void)hipFuncSetAttribute((const void*)k_phase<PH>, hipFuncAttributeMaxDynamicSharedMemorySize, LDS_BYTES); attr = true; }
  hipLaunchKernelGGL(k_phase<PH>, dim3(nblk), dim3(256), LDS_BYTES, stream, p);
}

extern "C" void kernel_launch(void* const* d_in, const int* in_sizes, int n_in, void* d_out, int out_size, void* d_ws, size_t ws_size, hipStream_t stream) {
  static int grid = 0;
  if (grid == 0) {
    if (n_in != 21 || ws_size < WS_TOTAL) { fprintf(stderr, "kernel_launch: unexpected n_in %d / ws %zu (need %zu)\n", n_in, ws_size, (size_t)WS_TOTAL); grid = -1; return; }
#if MEGA
    int dev = 0, cus = 0, per_cu = 0;
    (void)hipGetDevice(&dev);
    (void)hipDeviceGetAttribute(&cus, hipDeviceAttributeMultiprocessorCount, dev);
    (void)hipFuncSetAttribute((const void*)k_main, hipFuncAttributeMaxDynamicSharedMemorySize, LDS_BYTES);
    (void)hipOccupancyMaxActiveBlocksPerMultiprocessor(&per_cu, (const void*)k_main, 256, LDS_BYTES);
    if (per_cu < 1) per_cu = 1;
    if (per_cu > 2) per_cu = 2;
    grid = cus * per_cu;
    fprintf(stderr, "kernel_launch: cus %d per_cu %d grid %d\n", cus, per_cu, grid);
#else
    grid = 512;
#endif
  }
  if (grid < 0) return;
  P p{};
  for (int i = 0; i < 21; i++) p.in[i] = (const float*)d_in[i];
  p.out = (float*)d_out; p.ws = (char*)d_ws;
#if MEGA
  (void)hipMemsetAsync((char*)d_ws + WS_BAR, 0, WS_BAR_BYTES, stream);
  void* args[] = {&p};
  hipError_t e = hipLaunchCooperativeKernel((const void*)k_main, dim3(grid), dim3(256), args, LDS_BYTES, stream);
  if (e != hipSuccess) fprintf(stderr, "cooperative launch failed: %s (grid %d)\n", hipGetErrorString(e), grid);
#else
  launch_phase<0>(p, 2048, stream);
  launch_phase<1>(p, 264 * 12, stream);
  launch_phase<2>(p, 2112, stream);
  launch_phase<3>(p, 264 * 14, stream);
  launch_phase<4>(p, 64 * 17, stream);
  launch_phase<5>(p, 2048, stream);
  launch_phase<6>(p, 2048, stream);
  launch_phase<7>(p, 8192, stream);
#endif
}
```

```cpp
#include <hip/hip_runtime.h>
#include <hip/hip_cooperative_groups.h>
#include <stdint.h>
#include <cstdio>
namespace cg = cooperative_groups;

#ifndef MEGA
#define MEGA 1
#endif
#ifndef NAIVE_GEMM
#define NAIVE_GEMM 0
#endif
#ifndef NAIVE_ATTN
#define NAIVE_ATTN 0
#endif

#define DEVI __device__ __forceinline__

constexpr int DM = 1024;
constexpr int NBATCH = 8;
constexpr int SEQ = 4096;
constexpr int NMETA = 16;
constexpr int TP = 4224;
constexpr int NTOK = NBATCH * TP;
constexpr int NREAL = NBATCH * SEQ;
constexpr int ZW = 1408;
constexpr float EPS = 1e-6f;
constexpr float QSCALE = 0.14724574f;
constexpr float USCALE = 256.f, VSCALE = 64.f;

constexpr size_t al256(size_t x) { return (x + 255) & ~(size_t)255; }
constexpr size_t WS_WT_IN = 0;
constexpr size_t WS_WT_UQ = WS_WT_IN + al256((size_t)1536 * 1024 * 2);
constexpr size_t WS_WT_UK = WS_WT_UQ + al256((size_t)768 * 256 * 2);
constexpr size_t WS_WT_UV = WS_WT_UK + al256((size_t)512 * 128 * 2);
constexpr size_t WS_WT_OUT = WS_WT_UV + al256((size_t)512 * 128 * 2);
constexpr size_t WS_WT_PQ = WS_WT_OUT + al256((size_t)1024 * 1024 * 2);
constexpr size_t WS_KEYS = WS_WT_PQ + al256((size_t)1024 * 1024 * 2);
constexpr size_t WS_ROPE = WS_KEYS + al256((size_t)8 * 2 * 128 * 64 * 2);
constexpr size_t WS_U8 = WS_ROPE + al256((size_t)TP * 16 * 2 * 4);
constexpr size_t WS_V8 = WS_U8 + al256((size_t)16384 * 1024);
constexpr size_t WS_MIXED = WS_V8 + al256((size_t)16384 * 1024);
constexpr size_t WS_HB = WS_MIXED + al256((size_t)NTOK * 1024 * 2);
constexpr size_t WS_R1 = WS_HB + al256((size_t)NTOK * 1024 * 2);
constexpr size_t WS_Z = WS_R1;
constexpr size_t WS_KROPE = WS_Z + al256((size_t)NTOK * ZW * 2);
constexpr size_t WS_Q = WS_KROPE + al256((size_t)NTOK * 32 * 2);
constexpr size_t WS_KN = WS_Q + al256((size_t)NTOK * 768 * 2);
constexpr size_t WS_VT = WS_KN + al256((size_t)NTOK * 512 * 2);
constexpr size_t WS_R1_END = WS_VT + al256((size_t)NTOK * 512 * 2);
constexpr size_t WS_H2 = WS_R1;
constexpr size_t WS_SELI = WS_H2 + al256((size_t)NREAL * 1024 * 4);
constexpr size_t WS_SELG = WS_SELI + al256((size_t)NREAL * 128 * 4);
constexpr size_t WS_SEL_END = WS_SELG + al256((size_t)NREAL * 128 * 4);
static_assert(WS_SEL_END <= WS_R1_END, "overlay does not fit");
constexpr size_t WS_BAR = WS_R1_END;
constexpr size_t WS_BAR_BYTES = 16384;
constexpr size_t WS_TOTAL = WS_BAR + WS_BAR_BYTES;

constexpr int LDS_AS = 0;
constexpr int LDS_BS = 36864;
constexpr int LDS_RS = 73728;
constexpr int LDS_SCR = 73728 + 512;
constexpr int LDS_BYTES = LDS_SCR + 1024;
constexpr int CT_LD = 132;

struct P {
  const float* in[21];
  float* out;
  char* ws;
};

DEVI uint32_t f2bf(float f) { uint32_t u = __float_as_uint(f); return (u + 0x7fffu + ((u >> 16) & 1u)) >> 16; }
DEVI float bflo(uint32_t w) { return __uint_as_float(w << 16); }
DEVI float bfhi(uint32_t w) { return __uint_as_float(w & 0xffff0000u); }
DEVI float bf1(uint16_t h) { return __uint_as_float(((uint32_t)h) << 16); }
typedef __bf16 hwbf16x2 __attribute__((ext_vector_type(2)));
typedef float hwf32x2 __attribute__((ext_vector_type(2)));
DEVI uint32_t pk(float a, float b) { const hwf32x2 v = {a, b}; return __builtin_bit_cast(uint32_t, __builtin_convertvector(v, hwbf16x2)); }
DEVI float wsum16(float v) {
  v += __shfl_xor(v, 1); v += __shfl_xor(v, 2); v += __shfl_xor(v, 4); v += __shfl_xor(v, 8); return v;
}
DEVI float wsum64(float v) { v = wsum16(v); v += __shfl_xor(v, 16); v += __shfl_xor(v, 32); return v; }
DEVI uint32_t wmaxu(uint32_t v) {
#pragma unroll
  for (int o = 1; o < 64; o <<= 1) { uint32_t t = (uint32_t)__shfl_xor((int)v, o); v = v > t ? v : t; }
  return v;
}
DEVI uint32_t f2sort(float f) { return __float_as_uint(f); }
DEVI float sort2f(uint32_t s) { return __uint_as_float(s); }

typedef __attribute__((ext_vector_type(2))) __bf16 bf16x2_t;
DEVI float dot2bf(uint32_t a, uint32_t b, float acc) { return __builtin_amdgcn_fdot2_f32_bf16(__builtin_bit_cast(bf16x2_t, a), __builtin_bit_cast(bf16x2_t, b), acc, false); }
DEVI int tid_opaque() { int t = threadIdx.x; asm volatile("" : "+v"(t)); return t; }
typedef __attribute__((ext_vector_type(8))) short bf16x8;
typedef __attribute__((ext_vector_type(16))) float f32x16;

union Frag { bf16x8 v; uint32_t u[4]; uint2 d[2]; uint4 q; };
#define CE_DESC(x, y) { const float a_ = __uint_as_float(x), b_ = __uint_as_float(y); (x) = __float_as_uint(__builtin_fmaxf(a_, b_)); (y) = __float_as_uint(__builtin_fminf(a_, b_)); }
DEVI void sort16_desc(uint32_t (&a)[16]) {
#pragma unroll
  for (int k = 2; k <= 16; k <<= 1) {
#pragma unroll
    for (int j = k >> 1; j > 0; j >>= 1) {
#pragma unroll
      for (int i = 0; i < 16; i++) {
        const int l = i ^ j;
        if (l > i) { if ((i & k) == 0) CE_DESC(a[i], a[l]) else CE_DESC(a[l], a[i]) }
      }
    }
  }
}
DEVI void merge16_desc(uint32_t (&x)[16], const uint32_t (&y)[16]) {
#pragma unroll
  for (int i = 0; i < 16; i++) x[i] = __float_as_uint(__builtin_fmaxf(__uint_as_float(x[i]), __uint_as_float(y[15 - i])));
#pragma unroll
  for (int j = 8; j > 0; j >>= 1) {
#pragma unroll
    for (int i = 0; i < 16; i++) {
      const int l = i ^ j;
      if (l > i) CE_DESC(x[i], x[l])
    }
  }
}

DEVI const float* hrow_ptr(const P& p, int prow, bool& zero) {
  const int b = prow / TP, tt = prow - b * TP;
  zero = false;
  if (tt < NMETA) return p.in[1] + (size_t)tt * DM;
  if (tt < NMETA + SEQ) return p.in[0] + ((size_t)b * SEQ + (tt - NMETA)) * DM;
  zero = true; return p.in[0];
}

__device__ void phase_prep(const P& p, int vb, int nvb) {
  const size_t gid = (size_t)vb * 256 + tid_opaque(), gsz = (size_t)nvb * 256;
  char* ws = p.ws;
  {
    uint16_t* o = (uint16_t*)(ws + WS_WT_IN); const float* w = p.in[3]; const float* g = p.in[2];
    for (size_t i = gid; i < (size_t)512 * 1440; i += gsz) {
      const int k = 2 * (int)(i / 1440), n = (int)(i % 1440);
      *(uint32_t*)(o + (size_t)n * 1024 + k) = pk(w[(size_t)k * 1440 + n] * g[k], w[(size_t)(k + 1) * 1440 + n] * g[k + 1]);
    }
    for (size_t i = gid; i < (size_t)96 * 512; i += gsz) *(uint32_t*)(o + (size_t)1440 * 1024 + i * 2) = 0u;
  }
  {
    uint16_t* o = (uint16_t*)(ws + WS_WT_UQ); const float* w = p.in[5]; const float* g = p.in[4];
    for (size_t i = gid; i < (size_t)128 * 768; i += gsz) {
      const int k = 2 * (int)(i / 768), n = (int)(i % 768);
      *(uint32_t*)(o + (size_t)n * 256 + k) = pk(w[(size_t)k * 768 + n] * g[k] * QSCALE, w[(size_t)(k + 1) * 768 + n] * g[k + 1] * QSCALE);
    }
  }
  {
    uint16_t* ok = (uint16_t*)(ws + WS_WT_UK); uint16_t* ov = (uint16_t*)(ws + WS_WT_UV); const float* w = p.in[7]; const float* g = p.in[6];
    for (size_t i = gid; i < (size_t)64 * 1024; i += gsz) {
      const int k = 2 * (int)(i >> 10), c = (int)(i & 1023); const int h = c >> 7, d = c & 127;
      const uint32_t v = pk(w[(size_t)k * 1024 + c] * g[k], w[(size_t)(k + 1) * 1024 + c] * g[k + 1]);
      if (d < 64) *(uint32_t*)(ok + (size_t)(h * 64 + d) * 128 + k) = v; else *(uint32_t*)(ov + (size_t)(h * 64 + d - 64) * 128 + k) = v;
    }
  }
  {
    uint16_t* o = (uint16_t*)(ws + WS_WT_OUT); const float* w = p.in[14]; const float* ga = p.in[12]; const float* gc = p.in[13];
    for (size_t i = gid; i < (size_t)512 * 1024; i += gsz) {
      const int k = 2 * (int)(i >> 10), n = (int)(i & 1023);
      const float g0 = k < 512 ? ga[k] : gc[k - 512], g1 = k < 512 ? ga[k + 1] : gc[k + 1 - 512];
      *(uint32_t*)(o + (size_t)n * 1024 + k) = pk(w[(size_t)k * 1024 + n] * g0, w[(size_t)(k + 1) * 1024 + n] * g1);
    }
  }
  {
    uint16_t* o = (uint16_t*)(ws + WS_WT_PQ); const float* w = p.in[16]; const float* g = p.in[15];
    for (size_t i = gid; i < (size_t)512 * 1024; i += gsz) {
      const int k = 2 * (int)(i >> 10), n = (int)(i & 1023);
      *(uint32_t*)(o + (size_t)n * 1024 + k) = pk(w[(size_t)k * 1024 + n] * g[k], w[(size_t)(k + 1) * 1024 + n] * g[k + 1]);
    }
  }
  {
    uint16_t* o = (uint16_t*)(ws + WS_KEYS); const float* w = p.in[17];
    for (size_t i = gid; i < (size_t)8 * 2 * 128 * 64; i += gsz) o[i] = (uint16_t)f2bf(w[i]);
  }
  {
    float* ct = (float*)(ws + WS_ROPE); float* st = ct + TP * 16;
    for (size_t i = gid; i < (size_t)TP * 16; i += gsz) {
      int pos = (int)(i >> 4), j = (int)(i & 15);
      float fr = powf(10000.0f, -(float)j / 16.0f); float ang = (float)pos * fr;
      ct[i] = cosf(ang); st[i] = sinf(ang);
    }
  }
  {
    uint4* hb = (uint4*)(ws + WS_HB);
    for (size_t i = gid; i < (size_t)NTOK * 128; i += gsz) {
      const int prow = (int)(i >> 7), c = (int)(i & 127);
      bool zf; const float* src = hrow_ptr(p, prow, zf);
      uint4 o = make_uint4(0u, 0u, 0u, 0u);
      if (!zf) { const float4 a = *(const float4*)(src + c * 8), b = *(const float4*)(src + c * 8 + 4); o = make_uint4(pk(a.x, a.y), pk(a.z, a.w), pk(b.x, b.y), pk(b.z, b.w)); }
      hb[i] = o;
    }
  }
}

__device__ void convert_tables(const P& p, int vb, int nvb) {
  const size_t gid = (size_t)vb * 256 + tid_opaque(), gsz = (size_t)nvb * 256;
  char* ws = p.ws;
  {
    const float4* u = (const float4*)p.in[18]; const float4* v = (const float4*)p.in[19];
    uint4* ou = (uint4*)(ws + WS_U8); uint4* ov = (uint4*)(ws + WS_V8);
    for (size_t i = gid; i < (size_t)16384 * 1024 / 16; i += gsz) {
      uint32_t w[4];
#pragma unroll
      for (int q = 0; q < 4; q++) {
        const float4 a = u[i * 4 + q]; int x = 0;
        x = __builtin_amdgcn_cvt_pk_fp8_f32(a.x * USCALE, a.y * USCALE, x, false);
        x = __builtin_amdgcn_cvt_pk_fp8_f32(a.z * USCALE, a.w * USCALE, x, true);
        w[q] = (uint32_t)x;
      }
      ou[i] = make_uint4(w[0], w[1], w[2], w[3]);
#pragma unroll
      for (int q = 0; q < 4; q++) {
        const float4 a = v[i * 4 + q]; int x = 0;
        x = __builtin_amdgcn_cvt_pk_fp8_f32(a.x * VSCALE, a.y * VSCALE, x, false);
        x = __builtin_amdgcn_cvt_pk_fp8_f32(a.z * VSCALE, a.w * VSCALE, x, true);
        w[q] = (uint32_t)x;
      }
      ov[i] = make_uint4(w[0], w[1], w[2], w[3]);
    }
  }
}

template <int AMODE, bool TRANS, bool MID, int K>
DEVI void gemm_core(char* smem, const char* const (&arow)[4], const bool (&azero)[4], const uint16_t* __restrict__ Bt, int n0, int rot, int ktmask = 0xffff, int bm = 1) {
  uint16_t* As = (uint16_t*)(smem + LDS_AS);
  uint16_t* Bs = (uint16_t*)(smem + LDS_BS);
  float* rs = (float*)(smem + LDS_RS);
  float* Ct = (float*)smem;
  const int t = tid_opaque();
  const int kc = t & 7, r0 = t >> 3;
  constexpr int KT = K >> 6;
#if NAIVE_GEMM
  {
    const int ty = t >> 4, tx = t & 15;
    __syncthreads();
    const char** rp = (const char**)(smem + 40960); int* rz = (int*)(smem + 40960 + 1024);
    if (kc == 0) { for (int i = 0; i < 4; i++) { rp[r0 + 32 * i] = arow[i]; rz[r0 + 32 * i] = azero[i] ? 1 : 0; } }
    __syncthreads();
    float c[8][8];
    for (int i = 0; i < 8; i++) for (int j = 0; j < 8; j++) c[i][j] = 0.f;
    float sq[8] = {0, 0, 0, 0, 0, 0, 0, 0};
    const char* myrow[8]; int myz[8];
    for (int i = 0; i < 8; i++) { myrow[i] = rp[ty * 8 + i]; myz[i] = rz[ty * 8 + i]; }
    __syncthreads();
    for (int k = 0; k < K; k++) {
      if (MID && k == 512) {
        if (tx == 0) for (int i = 0; i < 8; i++) rs[ty * 8 + i] = rsqrtf(sq[i] / 512.f + EPS);
        __syncthreads();
        for (int i = 0; i < 8; i++) { float s = rs[ty * 8 + i]; for (int j = 0; j < 8; j++) c[i][j] *= s; }
      }
      float a[8], b[8];
      for (int i = 0; i < 8; i++) {
        float v;
        if (AMODE == 0) v = bf1(((const uint16_t*)myrow[i])[k]);
        else { v = myz[i] ? 0.f : ((const float*)myrow[i])[k]; }
        if (!MID || k < 512) sq[i] += v * v;
        a[i] = bf1((uint16_t)f2bf(v));
      }
      for (int j = 0; j < 8; j++) b[j] = bf1(Bt[(size_t)(n0 + tx * 8 + j) * K + k]);
      for (int i = 0; i < 8; i++) for (int j = 0; j < 8; j++) c[i][j] += a[i] * b[j];
    }
    __syncthreads();
    if (!MID && tx == 0) for (int i = 0; i < 8; i++) rs[ty * 8 + i] = rsqrtf(sq[i] / (float)K + EPS);
    for (int i = 0; i < 8; i++) for (int j = 0; j < 8; j++) {
      if (TRANS) Ct[(tx * 8 + j) * CT_LD + ty * 8 + i] = c[i][j]; else Ct[(ty * 8 + i) * CT_LD + tx * 8 + j] = c[i][j];
    }
    __syncthreads();
    return;
  }
#else
  const int wave = t >> 6, lane = t & 63, wm = wave >> 1, wn = wave & 1, lr = lane & 31, lh = lane >> 5;
  f32x16 acc[2][2];
#pragma unroll
  for (int i = 0; i < 2; i++)
#pragma unroll
    for (int j = 0; j < 2; j++)
#pragma unroll
      for (int r = 0; r < 16; r++) acc[i][j][r] = 0.f;
  uint4 xa00, xa01, xa02, xa03, xa10, xa11, xa12, xa13;
  uint4 xb00, xb01, xb02, xb03, xb10, xb11, xb12, xb13;
  float4 fa00, fa01, fa02, fa03, fa10, fa11, fa12, fa13;
  float4 fb00, fb01, fb02, fb03, fb10, fb11, fb12, fb13;
  float ssq0 = 0.f, ssq1 = 0.f, ssq2 = 0.f, ssq3 = 0.f;
  const float4 zero4 = make_float4(0.f, 0.f, 0.f, 0.f);
  const uint16_t* brow = Bt + (size_t)(n0 + r0 * bm) * K + kc * 8;
#define GL_LD1(i, S)                                                                                             \
  {                                                                                                              \
    if (AMODE == 0) {                                                                                            \
      xa##S##i = *(const uint4*)(arow[i] + ((size_t)kt_ * 64 + kc * 8) * 2);                                     \
    } else {                                                                                                     \
      fa##S##i = zero4; fb##S##i = zero4;                                                                        \
      if (!azero[i]) {                                                                                           \
        const float* src_ = (const float*)(arow[i]) + kt_ * 64 + kc * 8;                                         \
        fa##S##i = *(const float4*)src_; fb##S##i = *(const float4*)(src_ + 4);                                  \
      }                                                                                                          \
    }                                                                                                            \
    xb##S##i = *(const uint4*)(brow + (size_t)(32 * i * bm) * K + kt_ * 64);                                     \
  }
#define GL_LOAD(KT_, S) { int kt_ = MID ? (((KT_) & 8) | (((KT_) + rot) & 7)) : (((KT_) + rot) & (KT - 1)); kt_ &= ktmask; asm volatile("" : "+s"(kt_)); GL_LD1(0, S) GL_LD1(1, S) GL_LD1(2, S) GL_LD1(3, S) }
#define GL_ST1(i, S, BUF_, SSQ)                                                                                  \
  {                                                                                                              \
    uint4 ra_;                                                                                                   \
    if (AMODE == 0) {                                                                                            \
      ra_ = xa##S##i;                                                                                            \
      if (dossq_) {                                                                                              \
        SSQ = dot2bf(ra_.x, ra_.x, SSQ); SSQ = dot2bf(ra_.y, ra_.y, SSQ);                                        \
        SSQ = dot2bf(ra_.z, ra_.z, SSQ); SSQ = dot2bf(ra_.w, ra_.w, SSQ);                                        \
      }                                                                                                          \
    } else {                                                                                                     \
      const float4 f0 = fa##S##i, f1 = fb##S##i;                                                                 \
      if (dossq_) SSQ += f0.x * f0.x + f0.y * f0.y + f0.z * f0.z + f0.w * f0.w + f1.x * f1.x + f1.y * f1.y + f1.z * f1.z + f1.w * f1.w; \
      ra_ = make_uint4(pk(f0.x, f0.y), pk(f0.z, f0.w), pk(f1.x, f1.y), pk(f1.z, f1.w));                          \
    }                                                                                                            \
    *(uint4*)(As + (size_t)(BUF_) * 128 * 72 + (r0 + 32 * i) * 72 + kc * 8) = ra_;                               \
    *(uint4*)(Bs + (size_t)(BUF_) * 128 * 72 + (r0 + 32 * i) * 72 + kc * 8) = xb##S##i;                          \
  }
#define GL_STORE(BUF_, S, DOSSQ_) { const bool dossq_ = (DOSSQ_); GL_ST1(0, S, BUF_, ssq0) GL_ST1(1, S, BUF_, ssq1) GL_ST1(2, S, BUF_, ssq2) GL_ST1(3, S, BUF_, ssq3) }
#define GL_RS1(i, SSQ, DEN_)                                                                                     \
  {                                                                                                              \
    float s_ = SSQ;                                                                                              \
    s_ += __shfl_xor(s_, 1); s_ += __shfl_xor(s_, 2); s_ += __shfl_xor(s_, 4);                                   \
    if (kc == 0) rs[r0 + 32 * i] = rsqrtf(s_ / (DEN_) + EPS);                                                    \
  }
#define GL_RS(DEN_) { GL_RS1(0, ssq0, DEN_) GL_RS1(1, ssq1, DEN_) GL_RS1(2, ssq2, DEN_) GL_RS1(3, ssq3, DEN_) }
#define GL_COMPUTE(BUF_)                                                                                         \
  {                                                                                                              \
    const uint16_t* Ab = As + (size_t)(BUF_) * 128 * 72;                                                         \
    const uint16_t* Bb = Bs + (size_t)(BUF_) * 128 * 72;                                                         \
    _Pragma("unroll") for (int ks = 0; ks < 4; ks++) {                                                           \
      bf16x8 a[2], b[2];                                                                                         \
      _Pragma("unroll") for (int mi = 0; mi < 2; mi++) a[mi] = *(const bf16x8*)(Ab + (64 * wm + 32 * mi + lr) * 72 + 16 * ks + 8 * lh); \
      _Pragma("unroll") for (int ni = 0; ni < 2; ni++) b[ni] = *(const bf16x8*)(Bb + (64 * wn + 32 * ni + lr) * 72 + 16 * ks + 8 * lh); \
      _Pragma("unroll") for (int mi = 0; mi < 2; mi++)                                                           \
        _Pragma("unroll") for (int ni = 0; ni < 2; ni++) {                                                       \
          if (TRANS) acc[mi][ni] = __builtin_amdgcn_mfma_f32_32x32x16_bf16(b[ni], a[mi], acc[mi][ni], 0, 0, 0);  \
          else acc[mi][ni] = __builtin_amdgcn_mfma_f32_32x32x16_bf16(a[mi], b[ni], acc[mi][ni], 0, 0, 0);        \
        }                                                                                                        \
      if (ks == 1) __builtin_amdgcn_sched_barrier(0);                                                            \
    }                                                                                                            \
  }
  __syncthreads();
  GL_LOAD(0, 0);
  GL_LOAD(1, 1);
  GL_STORE(0, 0, true);
  __syncthreads();
  if (KT <= 4) {
    if (KT > 2) GL_LOAD(2, 0);
#pragma unroll
    for (int kt = 0; kt < KT; kt += 2) {
      GL_COMPUTE(0);
      GL_STORE(1, 1, true);
      if (kt + 3 < KT) GL_LOAD(kt + 3, 1);
      __syncthreads();
      GL_COMPUTE(1);
      if (kt + 2 < KT) {
        GL_STORE(0, 0, true);
        if (kt + 4 < KT) GL_LOAD(kt + 4, 0);
      }
      __syncthreads();
    }
  } else {
    GL_LOAD(2, 0);
#pragma unroll 1
    for (int kt = 0; kt < KT; kt += 2) {
      if (MID && kt == 8) {
        GL_RS(512.f);
        __syncthreads();
#pragma unroll
        for (int mi = 0; mi < 2; mi++) {
          f32x16 sv;
#pragma unroll
          for (int r = 0; r < 16; r++) sv[r] = rs[64 * wm + 32 * mi + (r & 3) + 8 * (r >> 2) + 4 * lh];
          acc[mi][0] *= sv; acc[mi][1] *= sv;
        }
      }
      GL_COMPUTE(0);
      GL_STORE(1, 1, !MID || (kt + 1) < 8);
      GL_LOAD((kt + 3 < KT ? kt + 3 : KT - 1), 1);
      __syncthreads();
      GL_COMPUTE(1);
      GL_STORE(0, 0, (kt + 2 < KT) && (!MID || (kt + 2) < 8));
      GL_LOAD((kt + 4 < KT ? kt + 4 : KT - 1), 0);
      __syncthreads();
    }
  }
  if (!MID) GL_RS((float)K);
#pragma unroll
  for (int mi = 0; mi < 2; mi++)
#pragma unroll
    for (int ni = 0; ni < 2; ni++)
#pragma unroll
      for (int r = 0; r < 16; r++) {
        const int ri = (r & 3) + 8 * (r >> 2) + 4 * lh;
        if (TRANS) Ct[(64 * wn + 32 * ni + ri) * CT_LD + 64 * wm + 32 * mi + lr] = acc[mi][ni][r];
        else Ct[(64 * wm + 32 * mi + ri) * CT_LD + 64 * wn + 32 * ni + lr] = acc[mi][ni][r];
      }
  __syncthreads();
#endif
}

__device__ void phase_gemm_z(const P& p, int vb, int nvb, char* smem) {
  const int t = tid_opaque(), kc = t & 7, r0 = t >> 3;
  const float* Ct = (const float*)smem; const float* rs = (const float*)(smem + LDS_RS);
  uint16_t* z = (uint16_t*)(p.ws + WS_Z); uint16_t* krope = (uint16_t*)(p.ws + WS_KROPE);
  const float* cost = (const float*)(p.ws + WS_ROPE); const float* sint = cost + TP * 16;
  const bool xs = (nvb & 7) == 0;
  const int xcd = vb & 7, slot = vb >> 3, nslot = nvb >> 3;
  for (int li = xs ? slot : vb; li < (xs ? 33 * 12 : 264 * 12); li += (xs ? nslot : nvb)) {
    const int mt = xs ? (li / 12) * 8 + xcd : li / 12, nt = li % 12;
    const char* arow[4]; const bool az[4] = {false, false, false, false};
#pragma unroll
    for (int i = 0; i < 4; i++) arow[i] = p.ws + WS_HB + (size_t)(mt * 128 + r0 + 32 * i) * 2048;
    gemm_core<0, false, false, 1024>(smem, arow, az, (const uint16_t*)(p.ws + WS_WT_IN), nt * 128, (nt * 4) / 3);
    const int c8 = t & 15;
    if (nt < 11) {
#pragma unroll
      for (int i = 0; i < 8; i++) {
        const int r = (t >> 4) + 16 * i; const float s = rs[r];
        const float4 v0 = *(const float4*)(Ct + r * CT_LD + c8 * 8), v1 = *(const float4*)(Ct + r * CT_LD + c8 * 8 + 4);
        uint4 o = make_uint4(pk(v0.x * s, v0.y * s), pk(v0.z * s, v0.w * s), pk(v1.x * s, v1.y * s), pk(v1.z * s, v1.w * s));
        *(uint4*)(z + (size_t)(mt * 128 + r) * ZW + nt * 128 + c8 * 8) = o;
      }
    } else if (c8 < 2) {
#pragma unroll
      for (int i = 0; i < 8; i++) {
        const int r = (t >> 4) + 16 * i; const float s = rs[r];
        const int prow = mt * 128 + r; const int pos = prow % TP;
        float o1[8], o2[8];
#pragma unroll
        for (int e = 0; e < 8; e++) {
          const int c = c8 * 8 + e;
          const float x1 = Ct[r * CT_LD + c] * s, x2 = Ct[r * CT_LD + c + 16] * s;
          const float cs = cost[pos * 16 + c], sn = sint[pos * 16 + c];
          o1[e] = x1 * cs - x2 * sn; o2[e] = x2 * cs + x1 * sn;
        }
        *(uint4*)(krope + (size_t)prow * 32 + c8 * 8) = make_uint4(pk(o1[0], o1[1]), pk(o1[2], o1[3]), pk(o1[4], o1[5]), pk(o1[6], o1[7]));
        *(uint4*)(krope + (size_t)prow * 32 + 16 + c8 * 8) = make_uint4(pk(o2[0], o2[1]), pk(o2[2], o2[3]), pk(o2[4], o2[5]), pk(o2[6], o2[7]));
      }
    }
  }
}

DEVI float fast_sigmoid(float x) { return __builtin_amdgcn_rcpf(1.f + __expf(-x)); }
__device__ void phase_conv(const P& p, int vb, int nvb, char* smem) {
  constexpr int CT = 24, NTL = 171;
  uint32_t* E0 = (uint32_t*)smem;
  uint32_t* E1 = E0 + 28 * 256;
  float* cv = (float*)smem;
  const int t = tid_opaque(), wave = t >> 6, lane = t & 63;
  const uint16_t* z = (const uint16_t*)(p.ws + WS_Z);
  uint16_t* mixed = (uint16_t*)(p.ws + WS_MIXED);
  const float* cw = p.in[8]; const float* cb = p.in[9]; const float* gl = p.in[10]; const float* bl = p.in[11];
  uint32_t wp0[16], wp1[16];
#pragma unroll
  for (int jp = 0; jp < 16; jp++) {
    const float2 wa = *(const float2*)(cw + (2 * jp) * 512 + 2 * t);
    float2 wb = make_float2(0.f, 0.f);
    if (jp < 15) wb = *(const float2*)(cw + (2 * jp + 1) * 512 + 2 * t);
    wp0[jp] = pk(wa.x, wb.x); wp1[jp] = pk(wa.y, wb.y);
  }
  const float bias0 = cb[2 * t], bias1 = cb[2 * t + 1];
  for (int tile = vb; tile < NBATCH * NTL; tile += nvb) {
    const int b = tile / NTL, t0 = NMETA + (tile - b * NTL) * CT;
    __syncthreads();
#pragma unroll 1
    for (int kb = 0; kb < 27; kb += 9) {
      uint32_t a2[18], b2[18];
#pragma unroll
      for (int u = 0; u < 18; u++) {
        const int tt = t0 - 30 + 2 * kb + u;
        const uint16_t* zr = z + (size_t)(b * TP + (tt < 0 ? 0 : tt)) * ZW;
        a2[u] = *(const uint32_t*)(zr + 2 * t); b2[u] = *(const uint32_t*)(zr + 512 + 2 * t);
      }
#pragma unroll
      for (int u = 0; u < 9; u++) {
        const int tt = t0 - 30 + 2 * (kb + u);
        float h00 = bflo(a2[2 * u]) * fast_sigmoid(bflo(b2[2 * u])), h01 = bfhi(a2[2 * u]) * fast_sigmoid(bfhi(b2[2 * u]));
        float h10 = bflo(a2[2 * u + 1]) * fast_sigmoid(bflo(b2[2 * u + 1])), h11 = bfhi(a2[2 * u + 1]) * fast_sigmoid(bfhi(b2[2 * u + 1]));
        if (tt < 0) { h00 = 0.f; h01 = 0.f; }
        if (tt + 1 < 0) { h10 = 0.f; h11 = 0.f; }
        E0[(kb + u) * 256 + t] = pk(h00, h10);
        E1[(kb + u) * 256 + t] = pk(h01, h11);
      }
    }
    E0[27 * 256 + t] = 0u; E1[27 * 256 + t] = 0u;
    float acc0[CT], acc1[CT];
#pragma unroll
    for (int ip = 0; ip < CT / 2; ip++) {
      float e0 = bias0, o0 = bias0, e1 = bias1, o1 = bias1;
      uint32_t pv0 = E0[ip * 256 + t], pv1 = E1[ip * 256 + t];
#pragma unroll
      for (int jp = 0; jp < 16; jp++) {
        const uint32_t nx0 = E0[(ip + jp + 1) * 256 + t], nx1 = E1[(ip + jp + 1) * 256 + t];
        e0 = dot2bf(pv0, wp0[jp], e0); e1 = dot2bf(pv1, wp1[jp], e1);
        o0 = dot2bf(__builtin_amdgcn_alignbyte(nx0, pv0, 2), wp0[jp], o0);
        o1 = dot2bf(__builtin_amdgcn_alignbyte(nx1, pv1, 2), wp1[jp], o1);
        pv0 = nx0; pv1 = nx1;
      }
      acc0[2 * ip] = e0; acc0[2 * ip + 1] = o0; acc1[2 * ip] = e1; acc1[2 * ip + 1] = o1;
    }
    __syncthreads();
#pragma unroll
    for (int i = 0; i < CT; i++) *(float2*)(cv + i * 512 + 2 * t) = make_float2(acc0[i], acc1[i]);
    __syncthreads();
    float gln[8], bln[8];
#pragma unroll
    for (int e = 0; e < 8; e++) { gln[e] = gl[lane * 8 + e]; bln[e] = bl[lane * 8 + e]; }
#pragma unroll 2
    for (int q = 0; q < CT / 4; q++) {
      const int tk = wave * (CT / 4) + q;
      float v[8];
      const float4 x0 = *(const float4*)(cv + tk * 512 + lane * 8), x1 = *(const float4*)(cv + tk * 512 + lane * 8 + 4);
      v[0] = x0.x; v[1] = x0.y; v[2] = x0.z; v[3] = x0.w; v[4] = x1.x; v[5] = x1.y; v[6] = x1.z; v[7] = x1.w;
      float s = 0.f;
#pragma unroll
      for (int e = 0; e < 8; e++) s += v[e];
      const float mu = wsum64(s) * (1.f / 512.f);
      float s2 = 0.f;
#pragma unroll
      for (int e = 0; e < 8; e++) { v[e] -= mu; s2 += v[e] * v[e]; }
      const float rstd = rsqrtf(wsum64(s2) * (1.f / 512.f) + EPS);
      float s3 = 0.f;
#pragma unroll
      for (int e = 0; e < 8; e++) {
        const float y = v[e] * rstd * gln[e] + bln[e];
        const float sl = y * fast_sigmoid(y);
        v[e] = sl; s3 += sl * sl;
      }
      const float r2 = rsqrtf(wsum64(s3) * (1.f / 512.f) + EPS);
      uint4 o = make_uint4(pk(v[0] * r2, v[1] * r2), pk(v[2] * r2, v[3] * r2), pk(v[4] * r2, v[5] * r2), pk(v[6] * r2, v[7] * r2));
      *(uint4*)(mixed + (size_t)(b * TP + t0 + tk) * 1024 + 512 + lane * 8) = o;
    }
  }
}

__device__ void phase_gemm_qkv(const P& p, int vb, int nvb, char* smem) {
  const int t = tid_opaque(), kc = t & 7, r0 = t >> 3;
  const float* Ct = (const float*)smem; const float* rs = (const float*)(smem + LDS_RS);
  const uint16_t* z = (const uint16_t*)(p.ws + WS_Z);
  uint16_t* Q = (uint16_t*)(p.ws + WS_Q); uint16_t* Kn = (uint16_t*)(p.ws + WS_KN); uint16_t* Vt = (uint16_t*)(p.ws + WS_VT);
  const float* cost = (const float*)(p.ws + WS_ROPE); const float* sint = cost + TP * 16;
  const bool az[4] = {false, false, false, false};
  for (int tile = vb; tile < 264 * 14; tile += nvb) {
    const int mt = tile / 14, nt = tile - mt * 14;
    const char* arow[4];
    if (nt < 6) {
#pragma unroll
      for (int i = 0; i < 4; i++) arow[i] = (const char*)(z + (size_t)(mt * 128 + r0 + 32 * i) * ZW + 1024);
      gemm_core<0, false, false, 256>(smem, arow, az, (const uint16_t*)(p.ws + WS_WT_UQ), nt * 128, nt);
      int te = threadIdx.x; asm volatile("" : "+v"(te)); const int c8 = te & 15, tq = te >> 4;
      const int gc = nt * 128 + c8 * 8; const int hd = gc / 96; const int d = gc - hd * 96;
#pragma unroll
      for (int i = 0; i < 8; i++) {
        const int r = tq + 16 * i; const float s = rs[r]; const int prow = mt * 128 + r;
        if (d < 64) {
          const float4 v0 = *(const float4*)(Ct + r * CT_LD + c8 * 8), v1 = *(const float4*)(Ct + r * CT_LD + c8 * 8 + 4);
          *(uint4*)(Q + (size_t)prow * 768 + gc) = make_uint4(pk(v0.x * s, v0.y * s), pk(v0.z * s, v0.w * s), pk(v1.x * s, v1.y * s), pk(v1.z * s, v1.w * s));
        } else if (d < 80) {
          const int pos = prow % TP; float o1[8], o2[8];
#pragma unroll
          for (int e = 0; e < 8; e++) {
            const int c = c8 * 8 + e; const int j = d - 64 + e;
            const float x1 = Ct[r * CT_LD + c] * s, x2 = Ct[r * CT_LD + c + 16] * s;
            const float cs = cost[pos * 16 + j], sn = sint[pos * 16 + j];
            o1[e] = x1 * cs - x2 * sn; o2[e] = x2 * cs + x1 * sn;
          }
          *(uint4*)(Q + (size_t)prow * 768 + gc) = make_uint4(pk(o1[0], o1[1]), pk(o1[2], o1[3]), pk(o1[4], o1[5]), pk(o1[6], o1[7]));
          *(uint4*)(Q + (size_t)prow * 768 + gc + 16) = make_uint4(pk(o2[0], o2[1]), pk(o2[2], o2[3]), pk(o2[4], o2[5]), pk(o2[6], o2[7]));
        }
      }
    } else if (nt < 10) {
      const int n0 = (nt - 6) * 128;
#pragma unroll
      for (int i = 0; i < 4; i++) arow[i] = (const char*)(z + (size_t)(mt * 128 + r0 + 32 * i) * ZW + 1280);
      gemm_core<0, false, false, 128>(smem, arow, az, (const uint16_t*)(p.ws + WS_WT_UK), n0, nt);
      int te = threadIdx.x; asm volatile("" : "+v"(te)); const int c8 = te & 15, tq = te >> 4;
#pragma unroll
      for (int i = 0; i < 8; i++) {
        const int r = tq + 16 * i; const float s = rs[r]; const int prow = mt * 128 + r;
        const float4 v0 = *(const float4*)(Ct + r * CT_LD + c8 * 8), v1 = *(const float4*)(Ct + r * CT_LD + c8 * 8 + 4);
        *(uint4*)(Kn + (size_t)prow * 512 + n0 + c8 * 8) = make_uint4(pk(v0.x * s, v0.y * s), pk(v0.z * s, v0.w * s), pk(v1.x * s, v1.y * s), pk(v1.z * s, v1.w * s));
      }
    } else {
      const int n0 = (nt - 10) * 128;
#pragma unroll
      for (int i = 0; i < 4; i++) arow[i] = (const char*)(z + (size_t)(mt * 128 + r0 + 32 * i) * ZW + 1280);
      gemm_core<0, true, false, 128>(smem, arow, az, (const uint16_t*)(p.ws + WS_WT_UV), n0, nt);
      int te = threadIdx.x; asm volatile("" : "+v"(te)); const int c8 = te & 15, tq = te >> 4;
      const int b = (mt * 128) / TP; const int tt0 = mt * 128 - b * TP;
      float sc[8];
#pragma unroll
      for (int e = 0; e < 8; e++) sc[e] = rs[c8 * 8 + e];
#pragma unroll
      for (int i = 0; i < 8; i++) {
        const int r = tq + 16 * i;
        const int n = n0 + r; const int hd = n >> 6, dv = n & 63;
        const float4 v0 = *(const float4*)(Ct + r * CT_LD + c8 * 8), v1 = *(const float4*)(Ct + r * CT_LD + c8 * 8 + 4);
        *(uint4*)(Vt + ((size_t)((b * 8 + hd) * 64 + dv)) * TP + tt0 + c8 * 8) =
            make_uint4(pk(v0.x * sc[0], v0.y * sc[1]), pk(v0.z * sc[2], v0.w * sc[3]), pk(v1.x * sc[4], v1.y * sc[5]), pk(v1.z * sc[6], v1.w * sc[7]));
      }
    }
  }
}

#if NAIVE_ATTN
__device__ void phase_attn(const P& p, int vb, int nvb, char* smem) {
  const uint16_t* Q = (const uint16_t*)(p.ws + WS_Q); const uint16_t* Kn = (const uint16_t*)(p.ws + WS_KN);
  const uint16_t* Vt = (const uint16_t*)(p.ws + WS_VT); const uint16_t* kr = (const uint16_t*)(p.ws + WS_KROPE);
  uint16_t* mixed = (uint16_t*)(p.ws + WS_MIXED);
  for (int item = vb; item < 64 * 17; item += nvb) {
    const int bh = item / 17, qc = item - bh * 17; const int b = bh >> 3, h = bh & 7;
    const int q = qc * 256 + threadIdx.x;
    const bool valid = q < TP; const int qq = valid ? q : TP - 1;
    float qv[96];
#pragma unroll
    for (int d = 0; d < 96; d++) qv[d] = bf1(Q[(size_t)(b * TP + qq) * 768 + h * 96 + d]);
    float o[64];
#pragma unroll
    for (int d = 0; d < 64; d++) o[d] = 0.f;
    float m = -INFINITY, l = 0.f;
    int kmax = qc * 256 + 255; if (kmax > TP - 1) kmax = TP - 1;
    for (int j = 0; j <= kmax; j++) {
      const uint16_t* kp = Kn + (size_t)(b * TP + j) * 512 + h * 64;
      const uint16_t* rp = kr + (size_t)(b * TP + j) * 32;
      float s = 0.f;
#pragma unroll
      for (int d = 0; d < 64; d++) s += qv[d] * bf1(kp[d]);
#pragma unroll
      for (int d = 0; d < 32; d++) s += qv[64 + d] * bf1(rp[d]);
      if (j > qq) s = -INFINITY;
      const float mn = fmaxf(m, s);
      const float alpha = exp2f(m - mn), pj = exp2f(s - mn);
      m = mn; l = l * alpha + pj;
      const uint16_t* vp = Vt + (size_t)((b * 8 + h) * 64) * TP + j;
#pragma unroll
      for (int d = 0; d < 64; d++) o[d] = o[d] * alpha + pj * bf1(vp[(size_t)d * TP]);
    }
    if (valid) {
      const float inv = 1.f / l;
      uint16_t* op = mixed + (size_t)(b * TP + q) * 1024 + h * 64;
#pragma unroll
      for (int d = 0; d < 64; d += 2) *(uint32_t*)(op + d) = pk(o[d] * inv, o[d + 1] * inv);
    }
  }
}
#endif

#if !NAIVE_ATTN
__device__ void phase_attn(const P& p, int vb, int nvb, char* smem) {
  const int t = tid_opaque(), wave = t >> 6, lane = t & 63, lr = lane & 31, lh = lane >> 5;
  const uint16_t* Q = (const uint16_t*)(p.ws + WS_Q); const uint16_t* Kn = (const uint16_t*)(p.ws + WS_KN);
  const uint16_t* Vt = (const uint16_t*)(p.ws + WS_VT); const uint16_t* kr = (const uint16_t*)(p.ws + WS_KROPE);
  uint16_t* mixed = (uint16_t*)(p.ws + WS_MIXED);
  constexpr int KP = 104, VP = 68;
  constexpr int KBYTES = 64 * KP * 2, BUFB = KBYTES + 64 * VP * 2;
  constexpr int NITEM = 64 * 33;
  if (vb & 1) convert_tables(p, vb, nvb);
  for (int rnd = 0; rnd * nvb < NITEM; rnd++) {
    const int it = (rnd & 1) ? rnd * nvb + (nvb - 1 - vb) : rnd * nvb + vb;
    if (it >= NITEM) continue;
    const int qb = 32 - (it >> 6), bh = it & 63, b = bh >> 3, h = bh & 7;
    const int q0 = qb * 128, nkt = 2 * qb + 2;
    const int qlo = q0 + 32 * wave, qrow = qlo + lr;
    const bool wreal = qlo < NMETA + SEQ;
    Frag qf[6];
#pragma unroll
    for (int s = 0; s < 6; s++) qf[s].q = *(const uint4*)(Q + (size_t)(b * TP + qrow) * 768 + h * 96 + 16 * s + 8 * lh);
    f32x16 o0, o1;
#pragma unroll
    for (int r = 0; r < 16; r++) { o0[r] = 0.f; o1[r] = 0.f; }
    float m = -INFINITY, l = 0.f;
    uint4 st0, st1, st2, st3, st4;
    const uint16_t* kbase = Kn + (size_t)(b * TP + (t >> 3)) * 512 + h * 64 + (t & 7) * 8;
    const uint16_t* rbase = kr + (size_t)(b * TP + (t >> 2)) * 32 + (t & 3) * 8;
    const uint16_t* vbase = Vt + ((size_t)((b * 8 + h) * 64 + (t >> 3))) * TP + (t & 7) * 8;
#define AT_LOAD(KT_)                                                    \
  {                                                                     \
    const int k0_ = (KT_) * 64;                                         \
    st0 = *(const uint4*)(kbase + (size_t)k0_ * 512);                   \
    st1 = *(const uint4*)(kbase + (size_t)(k0_ + 32) * 512);            \
    st2 = *(const uint4*)(rbase + (size_t)k0_ * 32);                    \
    st3 = *(const uint4*)(vbase + k0_);                                 \
    st4 = *(const uint4*)(vbase + (size_t)32 * TP + k0_);               \
  }
#define AT_STORE(BUF_)                                                                    \
  {                                                                                       \
    char* kl_ = smem + (BUF_) * BUFB; char* vl_ = kl_ + KBYTES;                           \
    *(uint4*)(kl_ + ((t >> 3) * KP + (t & 7) * 8) * 2) = st0;                             \
    *(uint4*)(kl_ + (((t >> 3) + 32) * KP + (t & 7) * 8) * 2) = st1;                      \
    *(uint4*)(kl_ + ((t >> 2) * KP + 64 + (t & 3) * 8) * 2) = st2;                        \
    *(uint4*)(vl_ + ((t >> 3) * VP + (t & 7) * 8) * 2) = st3;                             \
    *(uint4*)(vl_ + (((t >> 3) + 32) * VP + (t & 7) * 8) * 2) = st4;                      \
  }
    __syncthreads();
    AT_LOAD(0);
    AT_STORE(0);
    __syncthreads();
    for (int kt = 0; kt < nkt; kt++) {
      const int buf = kt & 1;
      if (kt + 1 < nkt) AT_LOAD(kt + 1);
      const int k0 = kt * 64;
      if (wreal && k0 <= qlo + 31) {
        const char* kl = smem + buf * BUFB; const char* vl = kl + KBYTES;
        f32x16 s0, s1;
#pragma unroll
        for (int r = 0; r < 16; r++) { s0[r] = 0.f; s1[r] = 0.f; }
#pragma unroll
        for (int s = 0; s < 6; s++) {
          const bf16x8 k0f = *(const bf16x8*)(kl + ((lr)*KP + 16 * s + 8 * lh) * 2);
          const bf16x8 k1f = *(const bf16x8*)(kl + ((32 + lr) * KP + 16 * s + 8 * lh) * 2);
          s0 = __builtin_amdgcn_mfma_f32_32x32x16_bf16(k0f, qf[s].v, s0, 0, 0, 0);
          s1 = __builtin_amdgcn_mfma_f32_32x32x16_bf16(k1f, qf[s].v, s1, 0, 0, 0);
        }
        if (k0 + 63 > qlo) {
#pragma unroll
          for (int r = 0; r < 16; r++) {
            const int key = k0 + (r & 3) + 8 * (r >> 2) + 4 * lh;
            if (key > qrow) s0[r] = -INFINITY;
            if (key + 32 > qrow) s1[r] = -INFINITY;
          }
        }
        float mxa = __builtin_fmaxf(__builtin_fmaxf(s0[0], s0[1]), s0[2]);
        float mxb = __builtin_fmaxf(__builtin_fmaxf(s1[0], s1[1]), s1[2]);
#pragma unroll
        for (int r = 3; r < 15; r += 2) {
          mxa = __builtin_fmaxf(__builtin_fmaxf(mxa, s0[r]), s0[r + 1]);
          mxb = __builtin_fmaxf(__builtin_fmaxf(mxb, s1[r]), s1[r + 1]);
        }
        float mx = __builtin_fmaxf(__builtin_fmaxf(mxa, s0[15]), __builtin_fmaxf(mxb, s1[15]));
        mx = fmaxf(mx, __shfl_xor(mx, 32));
        const float mn = fmaxf(m, mx);
        const float alpha = __builtin_amdgcn_exp2f(m - mn);
        const bool moved = __builtin_amdgcn_ballot_w64(mn > m) != 0ull;
        m = mn;
        float psum = 0.f;
#pragma unroll
        for (int r = 0; r < 16; r++) {
          s0[r] = __builtin_amdgcn_exp2f(s0[r] - mn); s1[r] = __builtin_amdgcn_exp2f(s1[r] - mn);
          psum += s0[r] + s1[r];
        }
        l = l * alpha + psum;
        if (moved) { o0 *= alpha; o1 *= alpha; }
#pragma unroll
        for (int kk = 0; kk < 2; kk++)
#pragma unroll
          for (int s2 = 0; s2 < 2; s2++) {
            Frag pf;
#pragma unroll
            for (int e = 0; e < 4; e++) pf.u[e] = kk == 0 ? pk(s0[8 * s2 + 2 * e], s0[8 * s2 + 2 * e + 1]) : pk(s1[8 * s2 + 2 * e], s1[8 * s2 + 2 * e + 1]);
            Frag v0f, v1f;
            const char* vp0 = vl + ((lr)*VP + 32 * kk + 16 * s2 + 4 * lh) * 2;
            const char* vp1 = vl + ((32 + lr) * VP + 32 * kk + 16 * s2 + 4 * lh) * 2;
            v0f.d[0] = *(const uint2*)vp0; v0f.d[1] = *(const uint2*)(vp0 + 16);
            v1f.d[0] = *(const uint2*)vp1; v1f.d[1] = *(const uint2*)(vp1 + 16);
            o0 = __builtin_amdgcn_mfma_f32_32x32x16_bf16(v0f.v, pf.v, o0, 0, 0, 0);
            o1 = __builtin_amdgcn_mfma_f32_32x32x16_bf16(v1f.v, pf.v, o1, 0, 0, 0);
          }
      }
      if (kt + 1 < nkt) AT_STORE(buf ^ 1);
      __syncthreads();
    }
    if (wreal) {
      const float lt = l + __shfl_xor(l, 32);
      const float inv = 1.f / lt;
      uint16_t* op = mixed + (size_t)(b * TP + qrow) * 1024 + h * 64 + 4 * lh;
#pragma unroll
      for (int rg = 0; rg < 4; rg++) {
        *(uint2*)(op + 8 * rg) = make_uint2(pk(o0[4 * rg] * inv, o0[4 * rg + 1] * inv), pk(o0[4 * rg + 2] * inv, o0[4 * rg + 3] * inv));
        *(uint2*)(op + 32 + 8 * rg) = make_uint2(pk(o1[4 * rg] * inv, o1[4 * rg + 1] * inv), pk(o1[4 * rg + 2] * inv, o1[4 * rg + 3] * inv));
      }
    }
  }
  if (!(vb & 1)) convert_tables(p, vb, nvb);
}
#endif

DEVI int prow_of(int rr) { return (rr >> 12) * TP + NMETA + (rr & 4095); }

__device__ void phase_gemm_out(const P& p, int vb, int nvb, char* smem, int var = 0) {
  const int t = tid_opaque(), r0 = t >> 3, c8 = t & 15;
  const float* Ct = (const float*)smem;
  const uint16_t* mixed = (const uint16_t*)(p.ws + WS_MIXED);
  float* h2 = (float*)(p.ws + WS_H2);
  const bool az[4] = {false, false, false, false};
  const bool xs = (nvb & 7) == 0;
  const int xcd = vb & 7, slot = vb >> 3, nslot = nvb >> 3;
  for (int li = xs ? slot : vb; li < (xs ? 32 * 8 : 256 * 8); li += (xs ? nslot : nvb)) {
    const int mt = xs ? (li >> 3) * 8 + xcd : li >> 3, nt = li & 7;
    const char* arow[4];
#pragma unroll
    for (int i = 0; i < 4; i++) arow[i] = (const char*)(mixed + (size_t)prow_of(mt * 128 + (var == 3 ? 0 : r0 + 32 * i)) * 1024);
    gemm_core<0, false, true, 1024>(smem, arow, az, (const uint16_t*)(p.ws + WS_WT_OUT), nt * 128, nt, var >= 2 ? 0 : 0xffff, var == 3 ? 0 : 1);
    if (var != 0) continue;
#pragma unroll
    for (int i = 0; i < 8; i++) {
      const int r = (t >> 4) + 16 * i; const int rr = mt * 128 + r;
      const float* xr = p.in[0] + (size_t)rr * DM + nt * 128 + c8 * 8;
      const float4 x0 = *(const float4*)xr, x1 = *(const float4*)(xr + 4);
      const float4 v0 = *(const float4*)(Ct + r * CT_LD + c8 * 8), v1 = *(const float4*)(Ct + r * CT_LD + c8 * 8 + 4);
      const float4 y0 = make_float4(x0.x + v0.x, x0.y + v0.y, x0.z + v0.z, x0.w + v0.w);
      const float4 y1 = make_float4(x1.x + v1.x, x1.y + v1.y, x1.z + v1.z, x1.w + v1.w);
      *(uint4*)(p.ws + WS_HB + ((size_t)rr * DM + nt * 128 + c8 * 8) * 2) = make_uint4(pk(y0.x, y0.y), pk(y0.z, y0.w), pk(y1.x, y1.y), pk(y1.z, y1.w));
      if (i & 1) __builtin_amdgcn_sched_barrier(0);
    }
  }
}

__device__ void phase_peer_q(const P& p, int vb, int nvb, char* smem) {
  const int t = tid_opaque(), r0 = t >> 3, wave = t >> 6, lane = t & 63, lr = lane & 31, lh = lane >> 5;
  float* Ct = (float*)smem; const float* rs = (const float*)(smem + LDS_RS);
  const float* h2 = (const float*)(p.ws + WS_H2);
  const uint16_t* keys = (const uint16_t*)(p.ws + WS_KEYS);
  int* seli = (int*)(p.ws + WS_SELI); float* selg = (float*)(p.ws + WS_SELG);
  const bool az[4] = {false, false, false, false};
  const bool xs = (nvb & 7) == 0;
  const int xcd = vb & 7, slot = vb >> 3, nslot = nvb >> 3;
  for (int li = xs ? slot : vb; li < (xs ? 32 * 8 : 256 * 8); li += (xs ? nslot : nvb)) {
    const int mt = xs ? (li >> 3) * 8 + xcd : li >> 3, hd = li & 7;
    const char* arow[4];
#pragma unroll
    for (int i = 0; i < 4; i++) arow[i] = p.ws + WS_HB + (size_t)(mt * 128 + r0 + 32 * i) * 2048;
    gemm_core<0, false, false, 1024>(smem, arow, az, (const uint16_t*)(p.ws + WS_WT_PQ), hd * 128, hd * 2);
    const int t2 = tid_opaque();
    const int wave2 = t2 >> 6, lr2 = t2 & 31, lh2 = (t2 >> 5) & 1;
    {
      const int r = t2 >> 1, c0 = (t2 & 1) * 64; const float rsv = rs[r];
      float4 tmp[16];
#pragma unroll
      for (int c = 0; c < 16; c++) tmp[c] = *(const float4*)(Ct + r * CT_LD + c0 + c * 4);
      __syncthreads();
      uint32_t* qrow = (uint32_t*)(smem + r * 272 + c0 * 2);
#pragma unroll
      for (int c = 0; c < 16; c++) { qrow[c * 2] = pk(tmp[c].x * rsv, tmp[c].y * rsv); qrow[c * 2 + 1] = pk(tmp[c].z * rsv, tmp[c].w * rsv); }
      __syncthreads();
    }
    uint32_t* svl = (uint32_t*)(smem + 34816);
    {
      const int tk = wave2 * 32 + lr2; const int rr = mt * 128 + tk;
      uint32_t sv0[16], sv1[16];
#pragma unroll 1
      for (int pp = 0; pp < 2; pp++) {
        f32x16 sc[4];
#pragma unroll
        for (int nt = 0; nt < 4; nt++)
#pragma unroll
          for (int r = 0; r < 16; r++) sc[nt][r] = 0.f;
#pragma unroll
        for (int ks = 0; ks < 4; ks++) {
          Frag qfr; qfr.q = *(const uint4*)(smem + tk * 272 + (pp * 64 + 16 * ks + 8 * lh2) * 2);
#pragma unroll
          for (int nt = 0; nt < 4; nt++) {
            Frag kf; kf.q = *(const uint4*)(keys + ((size_t)((hd * 2 + pp) * 128 + 32 * nt + lr2)) * 64 + 16 * ks + 8 * lh2);
            sc[nt] = __builtin_amdgcn_mfma_f32_32x32x16_bf16(kf.v, qfr.v, sc[nt], 0, 0, 0);
          }
          if (ks & 1) __builtin_amdgcn_sched_barrier(0);
        }
        uint32_t g0[16], g1[16], g2[16], g3[16];
#pragma unroll
        for (int r = 0; r < 16; r++) {
          const uint32_t n = (uint32_t)((r & 3) + 8 * (r >> 2) + 4 * lh2);
          g0[r] = (f2sort(sc[0][r]) & ~127u) | n;
          g1[r] = (f2sort(sc[1][r]) & ~127u) | (n + 32u);
          g2[r] = (f2sort(sc[2][r]) & ~127u) | (n + 64u);
          g3[r] = (f2sort(sc[3][r]) & ~127u) | (n + 96u);
        }
        __builtin_amdgcn_sched_barrier(0);
        sort16_desc(g0); sort16_desc(g1);
        __builtin_amdgcn_sched_barrier(0);
        sort16_desc(g2); sort16_desc(g3);
        __builtin_amdgcn_sched_barrier(0);
        merge16_desc(g0, g1); merge16_desc(g2, g3); merge16_desc(g0, g2);
        uint32_t y[16];
#pragma unroll
        for (int e = 0; e < 16; e++) y[e] = (uint32_t)__shfl_xor((int)g0[e], 32);
        merge16_desc(g0, y);
        {
          uint32_t* dst = svl + tk * 32 + pp * 16;
#pragma unroll
          for (int e = 0; e < 16; e += 4) *(uint4*)(dst + e) = make_uint4(g0[e], g0[e + 1], g0[e + 2], g0[e + 3]);
        }
      }
      asm volatile("s_waitcnt lgkmcnt(0)" ::: "memory");
#pragma unroll
      for (int e = 0; e < 16; e += 4) {
        const uint4 a0 = *(const uint4*)(svl + tk * 32 + e), a1 = *(const uint4*)(svl + tk * 32 + 16 + e);
        sv0[e] = a0.x; sv0[e + 1] = a0.y; sv0[e + 2] = a0.z; sv0[e + 3] = a0.w;
        sv1[e] = a1.x; sv1[e + 1] = a1.y; sv1[e + 2] = a1.z; sv1[e + 3] = a1.w;
      }
      __builtin_amdgcn_sched_barrier(0);
      float f0[16], f1[16];
#pragma unroll
      for (int e = 0; e < 16; e++) { f0[e] = sort2f(sv0[e] & ~127u); f1[e] = sort2f(sv1[e] & ~127u); }
      uint32_t c[32];
#define CPK(V_, C_) ((f2sort(V_) & ~255u) | (C_))
      c[0] = lh2 ? CPK(f0[2] + f1[1], 33u) : CPK(f0[0] + f1[0], 0u);
      c[1] = lh2 ? CPK(f0[2] + f1[2], 34u) : CPK(f0[0] + f1[1], 1u);
      c[2] = lh2 ? CPK(f0[2] + f1[3], 35u) : CPK(f0[0] + f1[2], 2u);
      c[3] = lh2 ? CPK(f0[2] + f1[4], 36u) : CPK(f0[0] + f1[3], 3u);
      c[4] = lh2 ? CPK(f0[3] + f1[0], 48u) : CPK(f0[0] + f1[4], 4u);
      c[5] = lh2 ? CPK(f0[3] + f1[1], 49u) : CPK(f0[0] + f1[5], 5u);
      c[6] = lh2 ? CPK(f0[3] + f1[2], 50u) : CPK(f0[0] + f1[6], 6u);
      c[7] = lh2 ? CPK(f0[3] + f1[3], 51u) : CPK(f0[0] + f1[7], 7u);
      c[8] = lh2 ? CPK(f0[4] + f1[0], 64u) : CPK(f0[0] + f1[8], 8u);
      c[9] = lh2 ? CPK(f0[4] + f1[1], 65u) : CPK(f0[0] + f1[9], 9u);
      c[10] = lh2 ? CPK(f0[4] + f1[2], 66u) : CPK(f0[0] + f1[10], 10u);
      c[11] = lh2 ? CPK(f0[5] + f1[0], 80u) : CPK(f0[0] + f1[11], 11u);
      c[12] = lh2 ? CPK(f0[5] + f1[1], 81u) : CPK(f0[0] + f1[12], 12u);
      c[13] = lh2 ? CPK(f0[6] + f1[0], 96u) : CPK(f0[0] + f1[13], 13u);
      c[14] = lh2 ? CPK(f0[6] + f1[1], 97u) : CPK(f0[0] + f1[14], 14u);
      c[15] = lh2 ? CPK(f0[7] + f1[0], 112u) : CPK(f0[0] + f1[15], 15u);
      c[16] = lh2 ? CPK(f0[7] + f1[1], 113u) : CPK(f0[1] + f1[0], 16u);
      c[17] = lh2 ? CPK(f0[8] + f1[0], 128u) : CPK(f0[1] + f1[1], 17u);
      c[18] = lh2 ? CPK(f0[9] + f1[0], 144u) : CPK(f0[1] + f1[2], 18u);
      c[19] = lh2 ? CPK(f0[10] + f1[0], 160u) : CPK(f0[1] + f1[3], 19u);
      c[20] = lh2 ? CPK(f0[11] + f1[0], 176u) : CPK(f0[1] + f1[4], 20u);
      c[21] = lh2 ? CPK(f0[12] + f1[0], 192u) : CPK(f0[1] + f1[5], 21u);
      c[22] = lh2 ? CPK(f0[13] + f1[0], 208u) : CPK(f0[1] + f1[6], 22u);
      c[23] = lh2 ? CPK(f0[14] + f1[0], 224u) : CPK(f0[1] + f1[7], 23u);
      c[24] = lh2 ? CPK(f0[15] + f1[0], 240u) : CPK(f0[2] + f1[0], 32u);
      c[25] = 0xff800000u;
      c[26] = 0xff800000u;
      c[27] = 0xff800000u;
      c[28] = 0xff800000u;
      c[29] = 0xff800000u;
      c[30] = 0xff800000u;
      c[31] = 0xff800000u;
#undef CPK
      __builtin_amdgcn_sched_barrier(0);
      uint32_t ca[16], cb[16];
#pragma unroll
      for (int e = 0; e < 16; e++) { ca[e] = c[e]; cb[e] = c[16 + e]; }
      sort16_desc(ca); sort16_desc(cb); merge16_desc(ca, cb);
#pragma unroll
      for (int e = 0; e < 16; e++) cb[e] = (uint32_t)__shfl_xor((int)ca[e], 32);
      merge16_desc(ca, cb);
      __builtin_amdgcn_sched_barrier(0);
      const float vfirst = sort2f(ca[0] & ~255u);
      float ev[16]; float esum = 0.f;
#pragma unroll
      for (int e = 0; e < 16; e++) { ev[e] = __expf(sort2f(ca[e] & ~255u) - vfirst); esum += ev[e]; }
      const float einv = 1.f / esum;
      int eo[8]; float go[8];
      const uint32_t hmask = lh2 ? 0xffffffffu : 0u;
#pragma unroll
      for (int e = 0; e < 8; e++) {
        const uint32_t key = ca[e] ^ ((ca[e] ^ ca[8 + e]) & hmask);
        const int cc = (int)(key & 255u); const int i = cc >> 4, j = cc & 15;
        eo[e] = (int)(svl[tk * 32 + i] & 127u) * 128 + (int)(svl[tk * 32 + 16 + j] & 127u);
        go[e] = __uint_as_float(__float_as_uint(ev[e]) ^ ((__float_as_uint(ev[e]) ^ __float_as_uint(ev[8 + e])) & hmask)) * einv;
      }
      int* ip = seli + (size_t)rr * 128 + hd * 16 + 8 * lh2; float* gp = selg + (size_t)rr * 128 + hd * 16 + 8 * lh2;
      *(int4*)ip = make_int4(eo[0], eo[1], eo[2], eo[3]); *(int4*)(ip + 4) = make_int4(eo[4], eo[5], eo[6], eo[7]);
      *(float4*)gp = make_float4(go[0], go[1], go[2], go[3]); *(float4*)(gp + 4) = make_float4(go[4], go[5], go[6], go[7]);
    }
  }
}

DEVI float gelu_exact(float x) { return 0.5f * x * (1.f + erff(x * 0.70710678118654752f)); }

typedef float f32x2 __attribute__((ext_vector_type(2)));
DEVI float4 ldbf4(const uint16_t* p) { const uint2 v = *(const uint2*)p; return make_float4(bflo(v.x), bfhi(v.x), bflo(v.y), bfhi(v.y)); }
__device__ void phase_gather(const P& p, int vb, int nvb, char* smem) {
  const int t = tid_opaque(), wave = t >> 6, lane = t & 63, g = lane >> 4, j = lane & 15;
  const uint16_t* h2 = (const uint16_t*)(p.ws + WS_HB);
  const int* seli = (const int*)(p.ws + WS_SELI); const float* selg = (const float*)(p.ws + WS_SELG);
  const uint8_t* U = (const uint8_t*)(p.ws + WS_U8); const uint8_t* V = (const uint8_t*)(p.ws + WS_V8);
  const float* gf = p.in[15]; const float* gfin = p.in[20];
  uint32_t* kl = (uint32_t*)smem + wave * 1024;
  float* wl = (float*)(kl + 512);
  for (int base = (vb * 4 + wave) * 4; base < NREAL; base += nvb * 16) {
    const int rr = base + g;
    const uint16_t* hr = h2 + (size_t)rr * DM;
    f32x2 xf[32];
    {
      float ss = 0.f;
#pragma unroll
      for (int i = 0; i < 4; i++)
#pragma unroll
        for (int q = 0; q < 4; q++) {
          const float4 a = ldbf4(hr + i * 256 + 16 * j + 4 * q);
          ss += a.x * a.x + a.y * a.y + a.z * a.z + a.w * a.w;
        }
      const float rstd = rsqrtf(wsum16(ss) * (1.f / 1024.f) + EPS);
#pragma unroll
      for (int i = 0; i < 4; i++) {
#pragma unroll
        for (int q = 0; q < 4; q++) {
          const float4 a = ldbf4(hr + i * 256 + 16 * j + 4 * q);
          const float4 ga = *(const float4*)(gf + i * 256 + 16 * j + 4 * q);
          xf[i * 8 + q * 2 + 0] = f32x2{bf1((uint16_t)f2bf(a.x * rstd * ga.x)), bf1((uint16_t)f2bf(a.y * rstd * ga.y))};
          xf[i * 8 + q * 2 + 1] = f32x2{bf1((uint16_t)f2bf(a.z * rstd * ga.z)), bf1((uint16_t)f2bf(a.w * rstd * ga.w))};
        }
        __builtin_amdgcn_sched_barrier(0);
      }
    }
    {
      uint32_t ks[8];
      {
        const int4 a0 = *(const int4*)(seli + (size_t)rr * 128 + j * 8), a1 = *(const int4*)(seli + (size_t)rr * 128 + j * 8 + 4);
        const int ev[8] = {a0.x, a0.y, a0.z, a0.w, a1.x, a1.y, a1.z, a1.w};
#pragma unroll
        for (int r = 0; r < 8; r++) ks[r] = ((uint32_t)ev[r] << 7) | (uint32_t)(j * 8 + r);
      }
#pragma unroll
      for (int k = 2; k <= 128; k <<= 1) {
#pragma unroll
        for (int d = k >> 1; d > 0; d >>= 1) {
          if (d >= 8) {
#pragma unroll
            for (int r = 0; r < 8; r++) {
              const uint32_t o = (uint32_t)__shfl_xor((int)ks[r], d >> 3);
              const bool up = (((j * 8 + r) & k) == 0), lower = (((j * 8) & d) == 0);
              const uint32_t mn = ks[r] < o ? ks[r] : o, mx = ks[r] < o ? o : ks[r];
              ks[r] = (lower == up) ? mn : mx;
            }
          } else {
#pragma unroll
            for (int r = 0; r < 8; r++) {
              if ((r & d) == 0) {
                const bool up = (((j * 8 + r) & k) == 0);
                const uint32_t x0 = ks[r], x1 = ks[r | d];
                const uint32_t mn = x0 < x1 ? x0 : x1, mx = x0 < x1 ? x1 : x0;
                ks[r] = up ? mn : mx; ks[r | d] = up ? mx : mn;
              }
            }
          }
        }
      }
      *(uint4*)(kl + g * 128 + j * 8) = make_uint4(ks[0], ks[1], ks[2], ks[3]);
      *(uint4*)(kl + g * 128 + j * 8 + 4) = make_uint4(ks[4], ks[5], ks[6], ks[7]);
    }
    asm volatile("s_waitcnt lgkmcnt(0)" ::: "memory");
    const float* sgp = selg + (size_t)rr * 128;
    const uint32_t* mykl = kl + g * 128;
    float* mywl = wl + g * 128;
    float gpre[8];
#pragma unroll
    for (int m = 0; m < 8; m++) gpre[m] = sgp[mykl[j + 16 * m] & 127u];
#pragma unroll 1
    for (int b0 = 0; b0 < 128; b0 += 8) {
      float dp[8];
#pragma unroll
      for (int u = 0; u < 8; u++) {
        const uint32_t key = mykl[b0 + u];
        const int e = (int)(key >> 7);
        const uint4* up = (const uint4*)(U + (size_t)e * 1024 + 16 * j);
        uint4 uu[4];
#pragma unroll
        for (int i = 0; i < 4; i++) uu[i] = up[i * 16];
        f32x2 d2 = f32x2{0.f, 0.f};
#pragma unroll
        for (int i = 0; i < 4; i++) {
          const uint32_t w[4] = {uu[i].x, uu[i].y, uu[i].z, uu[i].w};
#pragma unroll
          for (int q = 0; q < 4; q++) {
            d2 += __builtin_amdgcn_cvt_pk_f32_fp8((int)w[q], false) * xf[i * 8 + q * 2 + 0];
            d2 += __builtin_amdgcn_cvt_pk_f32_fp8((int)w[q], true) * xf[i * 8 + q * 2 + 1];
          }
        }
        dp[u] = d2.x + d2.y;
      }
      const bool h8 = (j & 8) != 0, h4 = (j & 4) != 0, h2b = (j & 2) != 0;
      float q4[4], q2[2];
#pragma unroll
      for (int k = 0; k < 4; k++) { const float snd = h8 ? dp[k] : dp[k + 4], kp = h8 ? dp[k + 4] : dp[k]; q4[k] = kp + __shfl_xor(snd, 8); }
#pragma unroll
      for (int k = 0; k < 2; k++) { const float snd = h4 ? q4[k] : q4[k + 2], kp = h4 ? q4[k + 2] : q4[k]; q2[k] = kp + __shfl_xor(snd, 4); }
      const float snd1 = h2b ? q2[0] : q2[1], kp1 = h2b ? q2[1] : q2[0];
      float q1 = kp1 + __shfl_xor(snd1, 2);
      q1 += __shfl_xor(q1, 1);
      if ((j & 1) == 0) mywl[b0 + (j >> 1)] = q1;
    }
    asm volatile("s_waitcnt lgkmcnt(0)" ::: "memory");
#pragma unroll
    for (int m = 0; m < 8; m++) {
      const int bb = j + 16 * m;
      const float d = mywl[bb] * (1.f / USCALE);
      mywl[bb] = gpre[m] * gelu_exact(d) * (1.f / VSCALE);
    }
    asm volatile("s_waitcnt lgkmcnt(0)" ::: "memory");
    f32x2 acc[32];
#pragma unroll
    for (int i = 0; i < 32; i++) acc[i] = f32x2{0.f, 0.f};
#pragma unroll 8
    for (int bb = 0; bb < 128; bb++) {
      const uint32_t key = mykl[bb];
      const int e = (int)(key >> 7);
      const float wgt = mywl[bb];
      const uint4* vp = (const uint4*)(V + (size_t)e * 1024 + 16 * j);
      uint4 vv[4];
#pragma unroll
      for (int i = 0; i < 4; i++) vv[i] = vp[i * 16];
      const f32x2 w2 = f32x2{wgt, wgt};
#pragma unroll
      for (int i = 0; i < 4; i++) {
        const uint32_t w[4] = {vv[i].x, vv[i].y, vv[i].z, vv[i].w};
#pragma unroll
        for (int q = 0; q < 4; q++) {
          acc[i * 8 + q * 2 + 0] += w2 * __builtin_amdgcn_cvt_pk_f32_fp8((int)w[q], false);
          acc[i * 8 + q * 2 + 1] += w2 * __builtin_amdgcn_cvt_pk_f32_fp8((int)w[q], true);
        }
      }
    }
    asm volatile("" ::: "memory");
    float ss = 0.f;
#pragma unroll
    for (int i = 0; i < 4; i++) {
#pragma unroll
      for (int q = 0; q < 4; q++) {
        const float4 a = ldbf4(hr + i * 256 + 16 * j + 4 * q);
        const float v0 = acc[i * 8 + q * 2].x + a.x, v1 = acc[i * 8 + q * 2].y + a.y, v2 = acc[i * 8 + q * 2 + 1].x + a.z, v3 = acc[i * 8 + q * 2 + 1].y + a.w;
        acc[i * 8 + q * 2] = f32x2{v0, v1}; acc[i * 8 + q * 2 + 1] = f32x2{v2, v3};
        ss += v0 * v0 + v1 * v1 + v2 * v2 + v3 * v3;
      }
      __builtin_amdgcn_sched_barrier(0);
    }
    const float rstd = rsqrtf(wsum16(ss) * (1.f / 1024.f) + EPS);
    float* orow = p.out + (size_t)rr * DM;
#pragma unroll
    for (int i = 0; i < 4; i++) {
#pragma unroll
      for (int q = 0; q < 4; q++) {
        const float4 ga = *(const float4*)(gfin + i * 256 + 16 * j + 4 * q);
        *(float4*)(orow + i * 256 + 16 * j + 4 * q) =
            make_float4(acc[i * 8 + q * 2].x * rstd * ga.x, acc[i * 8 + q * 2].y * rstd * ga.y, acc[i * 8 + q * 2 + 1].x * rstd * ga.z, acc[i * 8 + q * 2 + 1].y * rstd * ga.w);
      }
      __builtin_amdgcn_sched_barrier(0);
    }
  }
}

#define XB_TMO      128
#define XB_XCNT(j)  (256  + 64 * (j))
#define XB_XSUB(j)  (1280 + 64 * (j))
#define XB_XGEN(j)  (2304 + 64 * (j))
#define XB_TOP      3328
#define XB_TOPGEN   3392
#define XCD_BAR_WORDS 3456
#define XB_SPIN_CAP (1u << 18)
#define LAS __attribute__((address_space(3)))

__device__ __forceinline__ unsigned xb_ld(unsigned* p)              { return __hip_atomic_load(p, __ATOMIC_RELAXED, __HIP_MEMORY_SCOPE_AGENT); }
__device__ __forceinline__ unsigned xb_add(unsigned* p, unsigned v) { return __hip_atomic_fetch_add(p, v, __ATOMIC_RELAXED, __HIP_MEMORY_SCOPE_AGENT); }
__device__ __forceinline__ unsigned xb_xcc_id() { return (unsigned)__builtin_amdgcn_s_getreg((3 << 11) | 20) & 0xFu; }
#define XB_SPIN(cond, bar) do { unsigned _sp = 0; while (cond) { __builtin_amdgcn_s_sleep(1); \
    if ((++_sp & 255u) == 0u) { if (xb_ld(&(bar)[XB_TMO])) break; if (_sp > XB_SPIN_CAP) { atomicAdd(&(bar)[XB_TMO], 1u); break; } } } } while (0)

struct XcdBarrier {
    unsigned* bar; unsigned x;
    volatile LAS unsigned* st;
};

__device__ __forceinline__ XcdBarrier xcd_barrier_post(unsigned* bar, volatile LAS unsigned* st) {
    XcdBarrier b; b.bar = bar; b.x = xb_xcc_id(); b.st = st;
    if (threadIdx.x == 0) (void)xb_add(&bar[XB_XCNT(b.x)], 1u);
    return b;
}
__device__ __forceinline__ void xcd_barrier_complete(unsigned* bar, unsigned x, unsigned& nloc, unsigned& nx) {
    const unsigned G = gridDim.x * gridDim.y * gridDim.z;
    unsigned sum, cnt, mine, sp = 0u;
    for (;;) {
        sum = 0u; cnt = 0u; mine = 0u;
#pragma unroll
        for (unsigned j = 0; j < 16; ++j) { const unsigned c = xb_ld(&bar[XB_XCNT(j)]); sum += c; cnt += (c > 0u) ? 1u : 0u; mine = (j == x) ? c : mine; }
        if (sum == G) break;
        __builtin_amdgcn_s_sleep(1);
        if ((++sp & 255u) == 0u) { if (xb_ld(&bar[XB_TMO])) break; if (sp > XB_SPIN_CAP) { atomicAdd(&bar[XB_TMO], 1u); break; } }
    }
    nloc = mine > 0u ? mine : 1u; nx = cnt > 0u ? cnt : 1u;
}

__device__ __forceinline__ void xcd_barrier(const XcdBarrier& b) {
    asm volatile("s_waitcnt vmcnt(0)" ::: "memory");
    __syncthreads();
    if (threadIdx.x == 0) {
        unsigned* bar = b.bar;
        __builtin_amdgcn_s_waitcnt(0);
        unsigned nloc = b.st[0], nx = b.st[1];
        if (nloc == 0u) { xcd_barrier_complete(bar, b.x, nloc, nx); b.st[0] = nloc; b.st[1] = nx; }
        const unsigned old = xb_add(&bar[XB_XSUB(b.x)], 1u);
        const unsigned gen = old / nloc;
        if (old + 1u == (gen + 1u) * nloc) {
            __builtin_amdgcn_fence(__ATOMIC_RELEASE, "agent");
            asm volatile("s_waitcnt vmcnt(0)" ::: "memory");
            const unsigned og = xb_add(&bar[XB_TOP], 1u);
            const unsigned tg = og / nx;
            if (og + 1u == (tg + 1u) * nx) xb_add(&bar[XB_TOPGEN], 1u);
            else XB_SPIN(xb_ld(&bar[XB_TOPGEN]) == tg, bar);
            __builtin_amdgcn_fence(__ATOMIC_ACQUIRE, "agent");
            xb_add(&bar[XB_XGEN(b.x)], 1u);
            asm volatile("s_waitcnt vmcnt(0)" ::: "memory");
        } else {
            XB_SPIN(xb_ld(&bar[XB_XGEN(b.x)]) == gen, bar);
            __builtin_amdgcn_fence(__ATOMIC_ACQUIRE, "agent");
            asm volatile("s_waitcnt vmcnt(0)" ::: "memory");
        }
    }
    __syncthreads();
}

constexpr int NPHASE = 8;
template <int PH> DEVI void run_phase(const P& p, int vb, int nvb, char* smem, int var = 0) {
  if (PH == 0) phase_prep(p, vb, nvb);
  if (PH == 1) phase_gemm_z(p, vb, nvb, smem);
  if (PH == 2) phase_conv(p, vb, nvb, smem);
  if (PH == 3) phase_gemm_qkv(p, vb, nvb, smem);
  if (PH == 4) phase_attn(p, vb, nvb, smem);
  if (PH == 5) phase_gemm_out(p, vb, nvb, smem, var);
  if (PH == 6) phase_peer_q(p, vb, nvb, smem);
  if (PH == 7) phase_gather(p, vb, nvb, smem);
}
template <int PH> __global__ void __launch_bounds__(256, 2) k_phase(P p) {
  extern __shared__ __attribute__((aligned(16))) char smem[];
  run_phase<PH>(p, blockIdx.x, gridDim.x, smem);
}
#if MEGA
#ifndef PROBE_DUP
#define PROBE_DUP -1
#endif
#ifndef PROBE_VAR
#define PROBE_VAR 0
#endif
#define RUN_PH(N, SYNC)                                                    \
  _Pragma("unroll 1") for (int rep_ = 0; rep_ < (PROBE_DUP == N ? 2 : 1); rep_++) { \
    run_phase<N>(p, vb, nvb, smem, rep_ == 0 ? 0 : PROBE_VAR);             \
    if (SYNC || rep_ + 1 < (PROBE_DUP == N ? 2 : 1)) { if (N == 0) grid.sync(); else xcd_barrier(xb); } \
  }
__global__ void __launch_bounds__(256, 2) k_main(P p) {
  extern __shared__ __attribute__((aligned(16))) char smem[];
  const int vb = blockIdx.x, nvb = gridDim.x;
  cg::grid_group grid = cg::this_grid();
  __shared__ uint4 xb_words;
  if (threadIdx.x == 0) xb_words = make_uint4(0u, 0u, 0u, 0u);
  __syncthreads();
  const XcdBarrier xb = xcd_barrier_post((unsigned*)(p.ws + WS_BAR), (volatile LAS unsigned*)&xb_words);
  RUN_PH(0, true)
  RUN_PH(1, true)
  RUN_PH(2, (PROBE_DUP == 2))
  RUN_PH(3, true)
  RUN_PH(4, true)
  RUN_PH(5, true)
  RUN_PH(6, true)
  RUN_PH(7, false)
}
#endif

template <int PH> static void launch_phase(const P& p, int nblk, hipStream_t stream) {
  static bool attr = false;
  if (!attr) { (void)hipFuncSetAttribute((const void*)k_phase<PH>, hipFuncAttributeMaxDynamicSharedMemorySize, LDS_BYTES); attr = true; }
  hipLaunchKernelGGL(k_phase<PH>, dim3(nblk), dim3(256), LDS_BYTES, stream, p);
}

extern "C" void kernel_launch(void* const* d_in, const int* in_sizes, int n_in, void* d_out, int out_size, void* d_ws, size_t ws_size, hipStream_t stream) {
  static int grid = 0;
  if (grid == 0) {
    if (n_in != 21 || ws_size < WS_TOTAL) { fprintf(stderr, "kernel_launch: unexpected n_in %d / ws %zu (need %zu)\n", n_in, ws_size, (size_t)WS_TOTAL); grid = -1; return; }
#if MEGA
    int dev = 0, cus = 0, per_cu = 0;
    (void)hipGetDevice(&dev);
    (void)hipDeviceGetAttribute(&cus, hipDeviceAttributeMultiprocessorCount, dev);
    (void)hipFuncSetAttribute((const void*)k_main, hipFuncAttributeMaxDynamicSharedMemorySize, LDS_BYTES);
    (void)hipOccupancyMaxActiveBlocksPerMultiprocessor(&per_cu, (const void*)k_main, 256, LDS_BYTES);
    if (per_cu < 1) per_cu = 1;
    if (per_cu > 2) per_cu = 2;
    grid = cus * per_cu;
    fprintf(stderr, "kernel_launch: cus %d per_cu %d grid %d\n", cus, per_cu, grid);
#else
    grid = 512;
#endif
  }
  if (grid < 0) return;
  P p{};
  for (int i = 0; i < 21; i++) p.in[i] = (const float*)d_in[i];
  p.out = (float*)d_out; p.ws = (char*)d_ws;
#if MEGA
  (void)hipMemsetAsync((char*)d_ws + WS_BAR, 0, WS_BAR_BYTES, stream);
  void* args[] = {&p};
  hipError_t e = hipLaunchCooperativeKernel((const void*)k_main, dim3(grid), dim3(256), args, LDS_BYTES, stream);
  if (e != hipSuccess) fprintf(stderr, "cooperative launch failed: %s (grid %d)\n", hipGetErrorString(e), grid);
#else
  launch_phase<0>(p, 2048, stream);
  launch_phase<1>(p, 264 * 12, stream);
  launch_phase<2>(p, 2112, stream);
  launch_phase<3>(p, 264 * 14, stream);
  launch_phase<4>(p, 64 * 17, stream);
  launch_phase<5>(p, 2048, stream);
  launch_phase<6>(p, 2048, stream);
  launch_phase<7>(p, 8192, stream);
#endif
}
```
